# Optimizing an MI355X kernel written in HIP

```python
import math
import numpy as np
import jax
import jax.numpy as jnp
from jax import lax

D_MODEL = 2048
BATCH = 16
SEQ = 2048
DEPTH = 2

GRID_W = 64
CTX_LEN = 256
D_MIX = D_MODEL
SSD_HEADS = 12
SSD_HEADDIM = 64
SSD_W = SSD_HEADS * SSD_HEADDIM
SSD_GROUPS = 2
SSD_HPG = SSD_HEADS // SSD_GROUPS
SSD_STATE = 128
SSD_CONV = 4
SSD_CHUNK = 128
SSD_CONV_CH = SSD_W + 2 * SSD_GROUPS * SSD_STATE
POOL_WINDOWS = (2, 4, 8, 16)
POOL_GROUPS = 4
POOL_GC = 128
POOL_W = POOL_GROUPS * POOL_GC
MLA_HEADS = 6
MLA_NOPE = 128
MLA_ROPE = 64
MLA_QK = MLA_NOPE + MLA_ROPE
MLA_V = 128
MLA_W = MLA_HEADS * MLA_V
Q_LORA = 512
KV_LORA = 512
ROPE_BASE = 10000.0
Q_BLOCK = 128
FFN_DIM = 5632
N_EXPERTS = 8
TOP_K = 2
N_DENSE = (DEPTH + 1) // 2
N_MOE = DEPTH // 2
NORM_EPS = 1e-6
IN_SIZES = (SSD_W, SSD_CONV_CH, 2 * SSD_HEADS, POOL_W, Q_LORA, KV_LORA, MLA_ROPE)
D_IN = sum(IN_SIZES)

kernel_name = 'hybrid_ssd_pool_mla_prefix_dit_block'


def rms_norm(x, w):
    xf = x.astype(jnp.float32)
    y = xf * lax.rsqrt(jnp.mean(xf * xf, axis=-1, keepdims=True) + NORM_EPS)
    return y.astype(x.dtype) * w


def modulate(h, shift, scale):
    return h * (1.0 + scale) + shift


def split_cols(p, sizes):
    idx = np.cumsum(sizes)[:-1].tolist()
    return jnp.split(p, idx, axis=-1)


def rev(t):
    return jnp.flip(t, axis=1)


def dwconv(u, w, b):
    y = lax.conv_general_dilated(u, w[:, None, :], window_strides=(1,),
                                 padding=[(SSD_CONV // 2, SSD_CONV - 1 - SSD_CONV // 2)],
                                 dimension_numbers=('NWC', 'WIO', 'NWC'),
                                 feature_group_count=u.shape[-1])
    return y + b


def segsum(a):
    t = a.shape[-1]
    ae = jnp.broadcast_to(a[..., :, None], a.shape + (t,))
    strict = jnp.tril(jnp.ones((t, t), dtype=bool), -1)
    s = jnp.cumsum(jnp.where(strict, ae, 0.0), axis=-2)
    return jnp.where(jnp.tril(jnp.ones((t, t), dtype=bool)), s, -jnp.inf)


def ssd_scan(xh, dt, a, bm, cm, init_state):
    bsz, n = xh.shape[:2]
    nc = n // SSD_CHUNK
    x = xh.reshape(bsz, nc, SSD_CHUNK, SSD_GROUPS, SSD_HPG, SSD_HEADDIM)
    dtc = dt.reshape(bsz, nc, SSD_CHUNK, SSD_GROUPS, SSD_HPG)
    bc = bm.reshape(bsz, nc, SSD_CHUNK, SSD_GROUPS, SSD_STATE)
    cc = cm.reshape(bsz, nc, SSD_CHUNK, SSD_GROUPS, SSD_STATE)
    xdt = x * dtc[..., None].astype(x.dtype)
    adt = jnp.moveaxis(dtc * a, 2, -1)
    a_cs = jnp.cumsum(adt, axis=-1)
    decay_in = jnp.exp(segsum(adt)).astype(x.dtype)
    cb = jnp.einsum('bclgn,bcsgn->bcgls', cc, bc)
    y_diag = jnp.einsum('bcgrls,bcsgrp->bclgrp', cb[:, :, :, None] * decay_in, xdt)
    decay_to_end = jnp.exp(a_cs[..., -1:] - a_cs).astype(x.dtype)
    states = jnp.einsum('bcsgn,bcgrs,bcsgrp->bcgrpn', bc, decay_to_end, xdt)
    states = jnp.concatenate([init_state[:, None].astype(states.dtype), states], axis=1)
    a_chunk = jnp.pad(jnp.moveaxis(a_cs[..., -1], 1, -1), [(0, 0), (0, 0), (0, 0), (1, 0)])
    decay_chunk = jnp.exp(segsum(a_chunk)).astype(x.dtype)
    states = jnp.einsum('bgrzc,bcgrpn->bzgrpn', decay_chunk, states)
    decay_from_start = jnp.exp(a_cs).astype(x.dtype)
    y_off = jnp.einsum('bclgn,bcgrpn,bcgrl->bclgrp', cc, states[:, :-1], decay_from_start)
    y = (y_diag + y_off).reshape(bsz, n, SSD_GROUPS, SSD_HPG, SSD_HEADDIM)
    return y, states[:, -1]


def ssd_inputs(xbc_raw, dt_raw, conv_w, conv_b, dt_bias):
    bsz, n = xbc_raw.shape[:2]
    xbc = jax.nn.silu(dwconv(xbc_raw, conv_w, conv_b))
    xs, bm, cm = split_cols(xbc, (SSD_W, SSD_GROUPS * SSD_STATE, SSD_GROUPS * SSD_STATE))
    xs = xs.reshape(bsz, n, SSD_GROUPS, SSD_HPG, SSD_HEADDIM)
    bm = bm.reshape(bsz, n, SSD_GROUPS, SSD_STATE)
    cm = cm.reshape(bsz, n, SSD_GROUPS, SSD_STATE)
    dt = jax.nn.softplus(dt_raw.astype(jnp.float32).reshape(bsz, n, 2, SSD_HEADS)
                         + dt_bias.astype(jnp.float32))
    return xs, bm, cm, dt.reshape(bsz, n, 2, SSD_GROUPS, SSD_HPG)


def ssd_output(y, z, norm_w):
    bsz, n = y.shape[:2]
    return rms_norm(y.reshape(bsz, n, SSD_W) * jax.nn.silu(z), norm_w)


def multiscale_pool(u, pool_w, pool_scale):
    bsz, n, _ = u.shape
    uf = u.astype(jnp.float32)
    cs = jnp.concatenate([jnp.zeros((bsz, 1, POOL_W), jnp.float32), jnp.cumsum(uf, axis=1)], axis=1)
    t = jnp.arange(n)
    means = []
    for g, w in enumerate(POOL_WINDOWS):
        lo = jnp.clip(t - w // 2, 0, n)
        hi = jnp.clip(t - w // 2 + w, 0, n)
        cg = cs[:, :, g * POOL_GC:(g + 1) * POOL_GC]
        win_sum = jnp.take(cg, hi, axis=1) - jnp.take(cg, lo, axis=1)
        means.append(win_sum / (hi - lo).astype(jnp.float32)[None, :, None])
    pooled = (jnp.concatenate(means, axis=-1) - uf).astype(u.dtype)
    pooled = pooled.reshape(bsz, n, POOL_GROUPS, POOL_GC)
    y = jnp.einsum('blgc,gcd->blgd', pooled, pool_w).reshape(bsz, n, POOL_W)
    return y * pool_scale


def axial_rope(u, pos_row, pos_col):
    quarter = MLA_ROPE // 4
    inv = ROPE_BASE ** (-jnp.arange(quarter, dtype=jnp.float32) / quarter)
    ang = jnp.stack([pos_row, pos_col], axis=-1)[:, :, None] * inv
    cos = jnp.cos(ang)[None, :, None].astype(u.dtype)
    sin = jnp.sin(ang)[None, :, None].astype(u.dtype)
    ur = u.reshape(u.shape[:-1] + (2, 2, quarter))
    u1, u2 = ur[..., 0, :], ur[..., 1, :]
    out = jnp.stack([u1 * cos - u2 * sin, u2 * cos + u1 * sin], axis=-2)
    return out.reshape(u.shape)


def rope_part(t, pos):
    if pos is None:
        return t
    return jnp.concatenate([t[..., :MLA_NOPE], axial_rope(t[..., MLA_NOPE:], pos[0], pos[1])], axis=-1)


def mla_q(cq, q_norm_w, w_uq, qh_norm_w, pos):
    bsz, n = cq.shape[:2]
    q = (rms_norm(cq, q_norm_w) @ w_uq).reshape(bsz, n, MLA_HEADS, MLA_QK)
    return rope_part(rms_norm(q, qh_norm_w), pos)


def mla_kv(ckv, krope, kv_norm_w, w_ukv, kh_norm_w, pos):
    bsz, n = ckv.shape[:2]
    kv = (rms_norm(ckv, kv_norm_w) @ w_ukv).reshape(bsz, n, MLA_HEADS, MLA_NOPE + MLA_V)
    k_nope, v = kv[..., :MLA_NOPE], kv[..., MLA_NOPE:]
    k_r = jnp.broadcast_to(krope[:, :, None, :], (bsz, n, MLA_HEADS, MLA_ROPE))
    k = rms_norm(jnp.concatenate([k_nope, k_r], axis=-1), kh_norm_w)
    return rope_part(k, pos), v


def block_attention(q, k, v):
    bsz, lq, h, e = q.shape
    qb = jnp.moveaxis(q.reshape(bsz, lq // Q_BLOCK, Q_BLOCK, h, e), 1, 0)
    scale = e ** -0.5

    def one_block(qi):
        s = jnp.einsum('bqhe,bkhe->bhqk', qi, k).astype(jnp.float32) * scale
        p = jax.nn.softmax(s, axis=-1).astype(v.dtype)
        return jnp.einsum('bhqk,bkhd->bqhd', p, v)

    o = lax.map(one_block, qb)
    return jnp.moveaxis(o, 0, 1).reshape(bsz, lq, h * v.shape[-1])


def token_mixers(u_l, u_c, pos, with_ctx_out, w_in, conv_w, conv_b, dt_bias, a_log, d_skip,
                 ssd_norm_w, pool_w, pool_scale, q_norm_w, w_uq, kv_norm_w, w_ukv,
                 qh_norm_w, kh_norm_w, w_out):
    z_l, xbc_l, dtr_l, pool_l, cq_l, ckv_l, kr_l = split_cols(u_l @ w_in, IN_SIZES)
    z_c, xbc_c, dtr_c, pool_c, cq_c, ckv_c, kr_c = split_cols(u_c @ w_in, IN_SIZES)
    xs_l, b_l, c_l, dt_l = ssd_inputs(xbc_l, dtr_l, conv_w, conv_b, dt_bias)
    xs_c, b_c, c_c, dt_c = ssd_inputs(xbc_c, dtr_c, conv_w, conv_b, dt_bias)
    a = -jnp.exp(a_log.astype(jnp.float32)).reshape(2, SSD_GROUPS, SSD_HPG)
    zero = jnp.zeros((u_l.shape[0], SSD_GROUPS, SSD_HPG, SSD_HEADDIM, SSD_STATE), xs_l.dtype)
    yf_c, sf_c = ssd_scan(xs_c, dt_c[:, :, 0], a[0], b_c, c_c, zero)
    yf_l, _ = ssd_scan(xs_l, dt_l[:, :, 0], a[0], b_l, c_l, sf_c)
    yb_c, sb_c = ssd_scan(rev(xs_c), rev(dt_c[:, :, 1]), a[1], rev(b_c), rev(c_c), zero)
    yb_l, _ = ssd_scan(rev(xs_l), rev(dt_l[:, :, 1]), a[1], rev(b_l), rev(c_l), sb_c)
    d = d_skip.reshape(SSD_GROUPS, SSD_HPG, 1)
    ssd_l = ssd_output(yf_l + rev(yb_l) + xs_l * d, z_l, ssd_norm_w)
    pool_out_l = multiscale_pool(pool_l, pool_w, pool_scale)
    q_l = mla_q(cq_l, q_norm_w, w_uq, qh_norm_w, pos)
    k_l, v_l = mla_kv(ckv_l, kr_l, kv_norm_w, w_ukv, kh_norm_w, pos)
    k_c, v_c = mla_kv(ckv_c, kr_c, kv_norm_w, w_ukv, kh_norm_w, None)
    att_l = block_attention(q_l, jnp.concatenate([k_c, k_l], axis=1), jnp.concatenate([v_c, v_l], axis=1))
    m_l = jnp.concatenate([ssd_l, pool_out_l, att_l], axis=-1) @ w_out
    if not with_ctx_out:
        return m_l, None
    ssd_c = ssd_output(yf_c + rev(yb_c) + xs_c * d, z_c, ssd_norm_w)
    pool_out_c = multiscale_pool(pool_c, pool_w, pool_scale)
    att_c = block_attention(mla_q(cq_c, q_norm_w, w_uq, qh_norm_w, None), k_c, v_c)
    m_c = jnp.concatenate([ssd_c, pool_out_c, att_c], axis=-1) @ w_out
    return m_l, m_c


def swiglu(v, w_gate, w_up, w_down):
    return (jax.nn.silu(v @ w_gate) * (v @ w_up)) @ w_down


def moe_swiglu(v, w_router, w_gate, w_up, w_down):
    logits = (v @ w_router).astype(jnp.float32)
    top_val, top_idx = lax.top_k(logits, TOP_K)
    gates = jax.nn.softmax(top_val, axis=-1)
    weights = jnp.sum(jax.nn.one_hot(top_idx, N_EXPERTS, dtype=jnp.float32) * gates[..., None], axis=-2)
    out = jnp.zeros_like(v)
    for e in range(N_EXPERTS):
        out = out + weights[..., e:e + 1].astype(v.dtype) * swiglu(v, w_gate[e], w_up[e], w_down[e])
    return out


def channel_mixer(v, layer, ffn_w_gate, ffn_w_up, ffn_w_down, moe_w_router, moe_w_gate, moe_w_up, moe_w_down):
    j = layer // 2
    if layer % 2 == 0:
        return swiglu(v, ffn_w_gate[j], ffn_w_up[j], ffn_w_down[j])
    return moe_swiglu(v, moe_w_router[j], moe_w_gate[j], moe_w_up[j], moe_w_down[j])


def setup_inputs(seed: int = 0) -> dict:
    key = jax.random.key(seed)
    ks = iter(jax.random.split(key, 40))

    def nrm(shape, scale):
        return scale * jax.random.normal(next(ks), shape, jnp.float32)

    L = DEPTH
    dt0 = jnp.exp(jax.random.uniform(next(ks), (L, 2, SSD_HEADS), jnp.float32,
                                     minval=math.log(1e-3), maxval=math.log(1e-1)))
    dt_bias = dt0 + jnp.log(-jnp.expm1(-dt0))
    a_log = jnp.log(jax.random.uniform(next(ks), (L, 2, SSD_HEADS), jnp.float32, minval=1.0, maxval=16.0))
    return {
        'x': nrm((BATCH, SEQ, D_MODEL), 1.0),
        'c': nrm((BATCH, D_MODEL), 1.0),
        'ctx': nrm((BATCH, CTX_LEN, D_MODEL), 1.0),
        'c_ctx': nrm((D_MODEL,), 1.0),
        'ada_w': nrm((L, D_MODEL, 6 * D_MODEL), 0.5 * D_MODEL ** -0.5),
        'ada_b': nrm((L, 6 * D_MODEL), 0.01),
        'norm_mix_w': 1.0 + nrm((L, D_MODEL), 0.02),
        'norm_ffn_w': 1.0 + nrm((L, D_MODEL), 0.02),
        'w_in': nrm((L, D_MODEL, D_IN), D_MODEL ** -0.5),
        'ssd_conv_w': nrm((L, SSD_CONV, SSD_CONV_CH), SSD_CONV ** -0.5),
        'ssd_conv_b': nrm((L, SSD_CONV_CH), 0.01),
        'ssd_dt_bias': dt_bias,
        'ssd_a_log': a_log,
        'ssd_d': 1.0 + nrm((L, SSD_HEADS), 0.1),
        'ssd_norm_w': 1.0 + nrm((L, SSD_W), 0.02),
        'pool_w': nrm((L, POOL_GROUPS, POOL_GC, POOL_GC), POOL_GC ** -0.5),
        'pool_scale': 1.0 + nrm((L, POOL_W), 0.1),
        'mla_q_norm_w': 1.0 + nrm((L, Q_LORA), 0.02),
        'mla_w_uq': nrm((L, Q_LORA, MLA_HEADS * MLA_QK), Q_LORA ** -0.5),
        'mla_kv_norm_w': 1.0 + nrm((L, KV_LORA), 0.02),
        'mla_w_ukv': nrm((L, KV_LORA, MLA_HEADS * (MLA_NOPE + MLA_V)), KV_LORA ** -0.5),
        'mla_q_head_norm_w': 1.0 + nrm((L, MLA_QK), 0.02),
        'mla_k_head_norm_w': 1.0 + nrm((L, MLA_QK), 0.02),
        'w_out': nrm((L, D_MIX, D_MODEL), D_MIX ** -0.5),
        'ffn_w_gate': nrm((N_DENSE, D_MODEL, FFN_DIM), D_MODEL ** -0.5),
        'ffn_w_up': nrm((N_DENSE, D_MODEL, FFN_DIM), D_MODEL ** -0.5),
        'ffn_w_down': nrm((N_DENSE, FFN_DIM, D_MODEL), FFN_DIM ** -0.5),
        'moe_w_router': nrm((N_MOE, D_MODEL, N_EXPERTS), D_MODEL ** -0.5),
        'moe_w_gate': nrm((N_MOE, N_EXPERTS, D_MODEL, FFN_DIM), D_MODEL ** -0.5),
        'moe_w_up': nrm((N_MOE, N_EXPERTS, D_MODEL, FFN_DIM), D_MODEL ** -0.5),
        'moe_w_down': nrm((N_MOE, N_EXPERTS, FFN_DIM, D_MODEL), FFN_DIM ** -0.5),
    }


def reference(x, c, ctx, c_ctx, ada_w, ada_b, norm_mix_w, norm_ffn_w, w_in, ssd_conv_w, ssd_conv_b,
              ssd_dt_bias, ssd_a_log, ssd_d, ssd_norm_w, pool_w, pool_scale, mla_q_norm_w, mla_w_uq,
              mla_kv_norm_w, mla_w_ukv, mla_q_head_norm_w, mla_k_head_norm_w, w_out, ffn_w_gate,
              ffn_w_up, ffn_w_down, moe_w_router, moe_w_gate, moe_w_up, moe_w_down):
    seq = x.shape[1]
    rows = seq // GRID_W
    pos_row = jnp.repeat(jnp.arange(rows, dtype=jnp.float32), GRID_W)
    pos_col = jnp.tile(jnp.arange(GRID_W, dtype=jnp.float32), rows)
    pos = (pos_row, pos_col)
    s_lat = jax.nn.silu(c)[:, None, :]
    s_ctx = jax.nn.silu(c_ctx)[None, None, :]
    h_l, h_c = x, ctx
    for i in range(DEPTH):
        last = i == DEPTH - 1
        mod_l = jnp.split(s_lat @ ada_w[i] + ada_b[i], 6, axis=-1)
        mod_c = jnp.split(s_ctx @ ada_w[i] + ada_b[i], 6, axis=-1)
        u_l = modulate(rms_norm(h_l, norm_mix_w[i]), mod_l[0], mod_l[1])
        u_c = modulate(rms_norm(h_c, norm_mix_w[i]), mod_c[0], mod_c[1])
        m_l, m_c = token_mixers(u_l, u_c, pos, not last, w_in[i], ssd_conv_w[i], ssd_conv_b[i],
                                ssd_dt_bias[i], ssd_a_log[i], ssd_d[i], ssd_norm_w[i], pool_w[i],
                                pool_scale[i], mla_q_norm_w[i], mla_w_uq[i], mla_kv_norm_w[i],
                                mla_w_ukv[i], mla_q_head_norm_w[i], mla_k_head_norm_w[i], w_out[i])
        h_l = h_l + mod_l[2] * m_l
        v_l = modulate(rms_norm(h_l, norm_ffn_w[i]), mod_l[3], mod_l[4])
        h_l = h_l + mod_l[5] * channel_mixer(v_l, i, ffn_w_gate, ffn_w_up, ffn_w_down,
                                             moe_w_router, moe_w_gate, moe_w_up, moe_w_down)
        if not last:
            h_c = h_c + mod_c[2] * m_c
            v_c = modulate(rms_norm(h_c, norm_ffn_w[i]), mod_c[3], mod_c[4])
            h_c = h_c + mod_c[5] * channel_mixer(v_c, i, ffn_w_gate, ffn_w_up, ffn_w_down,
                                                 moe_w_router, moe_w_gate, moe_w_up, moe_w_down)
    return h_l
```

```cpp
#include <hip/hip_runtime.h>
#include <cstdio>
#include <cstdint>

#ifndef MK_N_LAUNCHES
#define MK_N_LAUNCHES 1
#endif

#ifndef DUP_PHASE
#define DUP_PHASE (-1)
#endif
#define NREP(k) (((k) == DUP_PHASE) ? 2 : 1)
#ifndef FP8_MOE_GU
#define FP8_MOE_GU 1
#endif
#ifndef FP8_MOE_DN
#define FP8_MOE_DN 1
#endif
#ifndef FP8_DENSE_GU
#define FP8_DENSE_GU 1
#endif
#ifndef FP8_DENSE_DN
#define FP8_DENSE_DN 1
#endif
#ifndef I8_DENSE_GU
#define I8_DENSE_GU 1
#endif
#ifndef FP8_QK
#define FP8_QK 1
#endif
#ifndef FP8_UQKV
#define FP8_UQKV 1
#endif
#ifndef FP8_PV
#define FP8_PV 1
#endif
#ifndef FP8_WOUT
#define FP8_WOUT 2
#endif
#ifndef I8_MOE_GU
#define I8_MOE_GU 1
#endif
#ifndef I8_INPROJ
#define I8_INPROJ 3
#endif
#ifndef FP8_INPROJ_L1
#define FP8_INPROJ_L1 0
#endif
#ifndef GEMM_DUP_PHASE
#define GEMM_DUP_PHASE (-1)
#endif
#define GREP(k) (((k) == GEMM_DUP_PHASE) ? 2 : 1)
#ifndef GEMM_STAGGER
#define GEMM_STAGGER 0
#endif
#ifndef MOE_PCT_A
#define MOE_PCT_A 25
#define MOE_PCT_W 37
#define MOE_PCT_B 62
#endif
#ifndef ATT_REP
#define ATT_REP 1
#endif
#ifndef SSD_TOUCH
#define SSD_TOUCH 0
#endif
#ifndef SSD_PROBE
#define SSD_PROBE 0
#endif
#ifndef HID_BLOCKED
#define HID_BLOCKED 1
#endif
#ifndef SSD_REP
#define SSD_REP 1
#endif
#define LAS __attribute__((address_space(3)))
#if FP8_QK && FP8_PV
#define ATT_QKFOLD 0.32267548f
#else
#define ATT_QKFOLD 1.0f
#endif
#define GAS __attribute__((address_space(1)))
typedef unsigned short bf16_t;
typedef short bf16x8 __attribute__((ext_vector_type(8)));
typedef float f32x4 __attribute__((ext_vector_type(4)));
typedef float f32x2 __attribute__((ext_vector_type(2)));
typedef unsigned u32x4 __attribute__((ext_vector_type(4)));
typedef unsigned u32x2 __attribute__((ext_vector_type(2)));
typedef int i32x4 __attribute__((ext_vector_type(4)));
typedef int i32x8 __attribute__((ext_vector_type(8)));

constexpr int DM = 2048, NB = 16, SEQ = 2048, CTXL = 256;
constexpr int TL = NB * SEQ, TC = NB * CTXL, TT = TL + TC;
constexpr int FF = 5632, NE = 8;
constexpr int D_IN = 3672;
constexpr int PC = 3840, PZ = 0, PXBC = 768, PPOOL = 2048, PCQ = 2560, PCKV = 3072, PKR = 3584, PDT = 3648;
constexpr int XAC = 1280;
constexpr int QC = 1280;
constexpr int KVC = 2048;
constexpr int NPMAX = 69632;
constexpr float EPS = 1e-6f;

constexpr size_t MiB = 1u << 20;
constexpr size_t WS_CTL = 0, CTL_BYTES = 1 * MiB;
constexpr size_t WS_SMALL = 1 * MiB;
constexpr size_t SM_MODL = 0;
constexpr size_t SM_MODC = 1572864;
constexpr size_t SM_ROPE = 1671168;
constexpr size_t SM_POOLB = 1679360;
constexpr size_t SM_TOPI = 2727936;
constexpr size_t SM_TOPW = 2990080;
constexpr size_t SM_ROWTOK = 3252224;
constexpr size_t SM_ROWW = 3530752;
constexpr size_t SM_TILEE = 3809280;
constexpr size_t SM_POS = 3811328;
constexpr size_t SM_CNTW = 4073472;
constexpr size_t SM_DT = 4 * MiB;
constexpr size_t SM_RS = 8 * MiB;
constexpr size_t SM_CS_DGU = SM_RS + 256 * 1024;
constexpr size_t SM_CS_WIN = SM_CS_DGU + 64 * 1024;
constexpr size_t SM_CS_MGU = SM_CS_WIN + 64 * 1024;
constexpr size_t SM_VPS = SM_CS_MGU + 512 * 1024;
constexpr size_t WS_WIN = 13 * MiB;
constexpr size_t WS_WOUT = WS_WIN + 30 * MiB;
constexpr size_t WS_WGU = WS_WOUT + 16 * MiB;
constexpr size_t WS_WDN = WS_WGU + 44 * MiB;
constexpr size_t WS_HC = WS_WDN + 22 * MiB;
constexpr size_t WS_U = WS_HC + 32 * MiB;
constexpr size_t WS_XA = WS_U, WS_PL = WS_U + 96 * MiB;
constexpr size_t WS_PAIR = WS_WIN;
constexpr size_t WS_WUQ = WS_U + 144 * MiB;
constexpr size_t WS_WUKV = WS_WUQ + 3 * MiB;
constexpr size_t WS_MWGU = WS_WUKV + 4 * MiB;
constexpr size_t WS_MWDN = WS_MWGU + 352 * MiB;
constexpr size_t WS_R = WS_MWDN + 176 * MiB;
constexpr size_t WS_P = WS_R;
constexpr size_t WS_QR = WS_P + 270 * MiB;
constexpr size_t WS_KVR = WS_QR + 90 * MiB;
constexpr size_t WS_YF = WS_KVR + 144 * MiB;
constexpr size_t WS_YB = WS_YF + 54 * MiB;
constexpr size_t WS_CAT = WS_YB + 54 * MiB;
constexpr size_t WS_VP8 = WS_WIN;
constexpr size_t WS_C8 = WS_YF;
constexpr size_t WS_HID = WS_R;
constexpr size_t WS_H16 = WS_R + 756 * MiB;
constexpr size_t WS_VT8 = WS_H16 + 144 * MiB;
constexpr size_t WS_END = WS_VT8 + 28 * MiB;
static_assert(WS_PAIR + (size_t)NPMAX * DM * 2 <= WS_U + 144 * MiB, "PAIR overlay");
static_assert(WS_VP8 + (size_t)NPMAX * DM <= WS_U, "VP8 overlay must stay clear of U (read while VP8 is written)");
static_assert(WS_HID + (size_t)NPMAX * FF * 2 <= WS_H16 && WS_CAT + (size_t)TT * DM * 2 <= WS_H16, "region R");
constexpr int CW_BAR = 4096;

__device__ __forceinline__ unsigned cvt_pk_bf16(float lo, float hi) { unsigned r; asm volatile("v_cvt_pk_bf16_f32 %0, %1, %2" : "=v"(r) : "v"(lo), "v"(hi)); return r; }
__device__ __forceinline__ float bf_lo(unsigned w) { return __uint_as_float(w << 16); }
__device__ __forceinline__ float bf_hi(unsigned w) { return __uint_as_float(w & 0xffff0000u); }
__device__ __forceinline__ float bf2f(bf16_t b) { return __uint_as_float(((unsigned)b) << 16); }
__device__ __forceinline__ bf16_t f2bf(float f) { return (bf16_t)(cvt_pk_bf16(f, 0.f) & 0xffffu); }
__device__ __forceinline__ unsigned pack4_fp8(float a, float b, float c, float d) {
    a = __builtin_amdgcn_fmed3f(a, -448.f, 448.f); b = __builtin_amdgcn_fmed3f(b, -448.f, 448.f); c = __builtin_amdgcn_fmed3f(c, -448.f, 448.f); d = __builtin_amdgcn_fmed3f(d, -448.f, 448.f);
    int w = 0; w = __builtin_amdgcn_cvt_pk_fp8_f32(a, b, w, false); w = __builtin_amdgcn_cvt_pk_fp8_f32(c, d, w, true); return (unsigned)w;
}
__device__ __forceinline__ unsigned pack4_i8(float a, float b, float c, float d) {
    unsigned w = 0;
    w = __builtin_amdgcn_cvt_pk_u8_f32(rintf(a + 128.f), 0, w); w = __builtin_amdgcn_cvt_pk_u8_f32(rintf(b + 128.f), 1, w);
    w = __builtin_amdgcn_cvt_pk_u8_f32(rintf(c + 128.f), 2, w); w = __builtin_amdgcn_cvt_pk_u8_f32(rintf(d + 128.f), 3, w);
    return w ^ 0x80808080u;
}
constexpr float W8_SCALE = 256.0f, W8_INV = 1.0f / 256.0f;
__device__ __forceinline__ float wave_sum(float v) {
#pragma unroll
    for (int o = 1; o < 64; o <<= 1) v += __shfl_xor(v, o);
    return v;
}
__device__ __forceinline__ float silu_f(float x) { return x * __builtin_amdgcn_rcpf(1.0f + __expf(-x)); }
#define LDS_WAIT() asm volatile("s_waitcnt lgkmcnt(0)" ::: "memory")
#define VM_WAIT() asm volatile("s_waitcnt vmcnt(0)" ::: "memory")

#define XB_TMO      128
#define XB_XCNT(j)  (256  + 64 * (j))
#define XB_XSUB(j)  (1280 + 64 * (j))
#define XB_XGEN(j)  (2304 + 64 * (j))
#define XB_TOP      3328
#define XB_TOPGEN   3392
#define XCD_BAR_WORDS 3456
#define XB_SPIN_CAP (1u << 20)
__device__ __forceinline__ unsigned xb_ld(unsigned* p)              { return __hip_atomic_load(p, __ATOMIC_RELAXED, __HIP_MEMORY_SCOPE_AGENT); }
__device__ __forceinline__ unsigned xb_add(unsigned* p, unsigned v) { return __hip_atomic_fetch_add(p, v, __ATOMIC_RELAXED, __HIP_MEMORY_SCOPE_AGENT); }
__device__ __forceinline__ unsigned xb_xcc_id() { return (unsigned)__builtin_amdgcn_s_getreg((3 << 11) | 20) & 0xFu; }
#define XB_SPIN(cond, bar) do { unsigned _sp = 0; while (cond) { __builtin_amdgcn_s_sleep(1); \
    if ((++_sp & 255u) == 0u) { if (xb_ld(&(bar)[XB_TMO])) break; if (_sp > XB_SPIN_CAP) { atomicAdd(&(bar)[XB_TMO], 1u); break; } } } } while (0)
struct XcdBarrier { unsigned* bar; unsigned x; volatile LAS unsigned* st; };
__device__ __forceinline__ XcdBarrier xcd_barrier_post(unsigned* bar, volatile LAS unsigned* st) {
    XcdBarrier b; b.bar = bar; b.x = xb_xcc_id(); b.st = st;
    if (threadIdx.x == 0) (void)xb_add(&bar[XB_XCNT(b.x)], 1u);
    return b;
}
__device__ __forceinline__ void xcd_barrier_complete(unsigned* bar, unsigned x, unsigned& nloc, unsigned& nx) {
    const unsigned G = gridDim.x * gridDim.y * gridDim.z;
    unsigned sum, cnt, mine, sp = 0u;
    for (;;) {
        sum = 0u; cnt = 0u; mine = 0u;
#pragma unroll
        for (unsigned j = 0; j < 16; ++j) { const unsigned c = xb_ld(&bar[XB_XCNT(j)]); sum += c; cnt += (c > 0u) ? 1u : 0u; mine = (j == x) ? c : mine; }
        if (sum == G) break;
        __builtin_amdgcn_s_sleep(1);
        if ((++sp & 255u) == 0u) { if (xb_ld(&bar[XB_TMO])) break; if (sp > XB_SPIN_CAP) { atomicAdd(&bar[XB_TMO], 1u); break; } }
    }
    nloc = mine > 0u ? mine : 1u; nx = cnt > 0u ? cnt : 1u;
}
__device__ __forceinline__ void xcd_barrier(const XcdBarrier& b) {
    asm volatile("s_waitcnt vmcnt(0)" ::: "memory");
    __syncthreads();
    if (threadIdx.x == 0) {
        unsigned* bar = b.bar;
        __builtin_amdgcn_s_waitcnt(0);
        unsigned nloc = b.st[0], nx = b.st[1];
        if (nloc == 0u) { xcd_barrier_complete(bar, b.x, nloc, nx); b.st[0] = nloc; b.st[1] = nx; }
        const unsigned old = xb_add(&bar[XB_XSUB(b.x)], 1u);
        const unsigned gen = old / nloc;
        if (old + 1u == (gen + 1u) * nloc) {
            __builtin_amdgcn_fence(__ATOMIC_RELEASE, "agent");
            asm volatile("s_waitcnt vmcnt(0)" ::: "memory");
            const unsigned og = xb_add(&bar[XB_TOP], 1u);
            const unsigned tg = og / nx;
            if (og + 1u == (tg + 1u) * nx) xb_add(&bar[XB_TOPGEN], 1u);
            else XB_SPIN(xb_ld(&bar[XB_TOPGEN]) == tg, bar);
            __builtin_amdgcn_fence(__ATOMIC_ACQUIRE, "agent");
            xb_add(&bar[XB_XGEN(b.x)], 1u);
            asm volatile("s_waitcnt vmcnt(0)" ::: "memory");
        } else {
            XB_SPIN(xb_ld(&bar[XB_XGEN(b.x)]) == gen, bar);
            __builtin_amdgcn_fence(__ATOMIC_ACQUIRE, "agent");
            asm volatile("s_waitcnt vmcnt(0)" ::: "memory");
        }
    }
    __syncthreads();
}

namespace pg8 {
constexpr int BM = 256, BK = 64, HALF = 128, HTB = HALF * BK * 2, STAGE_BYTES = 8 * HTB, NXCD = 8, WGM = 4;
__host__ __device__ __forceinline__ int lds_byte(int r, int c) { const int st = (r >> 4) * 2 + (c >> 5), rr = r & 15, cc = c & 31, ob = rr * 64 + cc * 2; return st * 1024 + (ob ^ (((ob >> 9) & 1) << 5)); }
__host__ __device__ __forceinline__ void stage_rc(int b, int& R, int& C) { const int st = b / 1024, sb = b % 1024, swz = sb ^ (((sb >> 9) & 1) << 5); R = (st >> 1) * 16 + swz / 64; C = (st & 1) * 32 + (swz % 64) / 2; }
__host__ __device__ __forceinline__ int perm32(int rho) { const int n = rho >> 4, i = rho & 15; return 8 * (i >> 2) + 4 * n + (i & 3); }
struct Unit { int pm, pn; };
struct Gemm { const bf16_t* A; const bf16_t* Bt; int lda, K; size_t akstep = 0, atile = 0; };

struct StaticOrder {
    int nM, nN, nwg, G, c, rep = 1;
    __device__ void init(int nM_, int nN_, int G_, int c_) { nM = nM_; nN = nN_; nwg = nM * nN; G = G_; c = c_; }
    __device__ bool next(int i, Unit& u) const {
        const long L = (long)i * G + c; if (L >= (long)nwg * rep) return false;
        int wgid = (int)(L % nwg); { const int q = nwg / NXCD, r = nwg % NXCD, xcd = wgid % NXCD, off = wgid / NXCD; wgid = (xcd < r ? xcd * (q + 1) : r * (q + 1) + (xcd - r) * q) + off; }
        const int nig = WGM * nN, gid = wgid / nig, fm = gid * WGM, gsz = (nM - fm) < WGM ? (nM - fm) : WGM;
        u.pm = fm + ((wgid % nig) % gsz); u.pn = (wgid % nig) / gsz; return true;
    }
    __device__ __forceinline__ size_t b_row0(const Unit& u) const { return (size_t)u.pn * BM; }
};
struct InProjL1Order {
    StaticOrder lat; int G, c;
    __device__ void init(int G_, int c_) { lat.init(TL / 256, PC / 256, G_, c_); G = G_; c = c_; }
    __device__ bool next(int i, Unit& u) const {
        if (lat.next(i, u)) return true;
        const long L = (long)i * G + c - lat.nwg; if (L < 0 || L >= 128) return false;
        const int j = (int)L & 7; u.pm = 128 + ((int)L >> 3); u.pn = j < 5 ? 3 + j : 7 + j; return true;
    }
    __device__ __forceinline__ size_t b_row0(const Unit& u) const { return (size_t)u.pn * BM; }
};
struct MoeOrder : StaticOrder {
    const int* tile_e; const int* rowtok; int rows_per_expert;
    __device__ __forceinline__ size_t b_row0(const Unit& u) const { return (size_t)tile_e[u.pm] * rows_per_expert + (size_t)u.pn * BM; }
};

struct EpiBf16 {
    static constexpr bool PERM = true;
    bf16_t* O; int ldc; float sc = 1.0f;
    __device__ __forceinline__ void operator()(const f32x4 (&acc)[2][2][4][2], const Unit& u, int wr, int wc, int fr, int fq) const {
        const int row0 = u.pm * BM + wr * 64 + fr, col0 = u.pn * BM + wc * 32 + 8 * fq;
#pragma unroll
        for (int ai = 0; ai < 2; ++ai)
#pragma unroll
            for (int m = 0; m < 4; ++m) { bf16_t* rowp = O + (size_t)(row0 + ai * HALF + m * 16) * ldc + col0;
#pragma unroll
                for (int bj = 0; bj < 2; ++bj) { const f32x4 v0 = acc[ai][bj][m][0] * sc, v1 = acc[ai][bj][m][1] * sc;
                    u32x4 w; w.x = cvt_pk_bf16(v0[0], v0[1]); w.y = cvt_pk_bf16(v0[2], v0[3]); w.z = cvt_pk_bf16(v1[0], v1[1]); w.w = cvt_pk_bf16(v1[2], v1[3]);
                    *(u32x4*)(rowp + bj * HALF) = w; } }
    }
};
template <bool OUT8> struct EpiGateUp {
    static constexpr bool PERM = true;
    void* O; int ldc; float sc; int nkt = 0;
    __device__ __forceinline__ void operator()(const f32x4 (&acc)[2][2][4][2], const Unit& u, int wr, int wc, int fr, int fq) const {
        const int row0 = u.pm * BM + wr * 64 + fr, col0 = u.pn * HALF + wc * 32 + 8 * fq;
#pragma unroll
        for (int ai = 0; ai < 2; ++ai)
#pragma unroll
            for (int m = 0; m < 4; ++m) { const size_t eo = (OUT8 && nkt) ? ((size_t)(u.pm * nkt + u.pn) * BM + (wr * 64 + fr + ai * HALF + m * 16)) * HALF + wc * 32 + 8 * fq : (size_t)(row0 + ai * HALF + m * 16) * ldc + col0;
                float h[8];
                const float c1 = -sc * 1.4426950408889634f, sc2 = sc * sc;
#pragma unroll
                for (int n = 0; n < 2; ++n)
#pragma unroll
                    for (int q = 0; q < 2; ++q) { const f32x2 g = {acc[ai][0][m][n][2 * q], acc[ai][0][m][n][2 * q + 1]}, up = {acc[ai][1][m][n][2 * q], acc[ai][1][m][n][2 * q + 1]};
                        const f32x2 t = (g * up) * sc2, a = g * c1; f32x2 e; e.x = __builtin_amdgcn_exp2f(a.x); e.y = __builtin_amdgcn_exp2f(a.y);
                        const f32x2 d = e + 1.0f; f32x2 r; r.x = __builtin_amdgcn_rcpf(d.x); r.y = __builtin_amdgcn_rcpf(d.y);
                        const f32x2 hv = t * r; h[n * 4 + 2 * q] = hv.x; h[n * 4 + 2 * q + 1] = hv.y; }
                if constexpr (OUT8) { u32x2 w; w.x = pack4_fp8(h[0], h[1], h[2], h[3]); w.y = pack4_fp8(h[4], h[5], h[6], h[7]); *(u32x2*)((unsigned char*)O + eo) = w; }
                else { u32x4 w; w.x = cvt_pk_bf16(h[0], h[1]); w.y = cvt_pk_bf16(h[2], h[3]); w.z = cvt_pk_bf16(h[4], h[5]); w.w = cvt_pk_bf16(h[6], h[7]); *(u32x4*)((bf16_t*)O + eo) = w; } }
    }
};
struct EpiResid {
    static constexpr bool PERM = false;
    const float* srcL; float* dstL; const float* srcC; float* dstC; const float* gateL; const float* gateC;
    float sc = 1.0f;
    __device__ __forceinline__ void operator()(const f32x4 (&acc)[2][2][4][2], const Unit& u, int wr, int wc, int fr, int fq) const {
        const bool lat = u.pm < 128;
        const float* src = lat ? srcL + (size_t)u.pm * BM * DM : srcC + (size_t)(u.pm - 128) * BM * DM;
        float* dst = lat ? dstL + (size_t)u.pm * BM * DM : dstC + (size_t)(u.pm - 128) * BM * DM;
        const float* gate = lat ? gateL + (size_t)(u.pm >> 3) * 12288 : gateC;
        const int row0 = wr * 64 + fr, col0 = u.pn * BM + wc * 32 + 4 * fq;
        f32x4 gv[2][2];
#pragma unroll
        for (int bj = 0; bj < 2; ++bj)
#pragma unroll
            for (int n = 0; n < 2; ++n) gv[bj][n] = *(const f32x4*)(gate + col0 + bj * HALF + n * 16) * sc;
#pragma unroll
        for (int ai = 0; ai < 2; ++ai)
#pragma unroll
            for (int m = 0; m < 4; ++m) { const size_t off = (size_t)(row0 + ai * HALF + m * 16) * DM + col0;
#pragma unroll
                for (int bj = 0; bj < 2; ++bj)
#pragma unroll
                    for (int n = 0; n < 2; ++n) { const f32x4 s = *(const f32x4*)(src + off + bj * HALF + n * 16); *(f32x4*)(dst + off + bj * HALF + n * 16) = s + gv[bj][n] * acc[ai][bj][m][n]; }
                if (m & 1) asm volatile("" ::: "memory"); }
    }
};
struct EpiF8 {
    static constexpr bool PERM = true;
    unsigned char* O; int ldc; float sc;
    __device__ __forceinline__ void operator()(const f32x4 (&acc)[2][2][4][2], const Unit& u, int wr, int wc, int fr, int fq) const {
        const int row0 = u.pm * BM + wr * 64 + fr, col0 = u.pn * BM + wc * 32 + 8 * fq;
#pragma unroll
        for (int ai = 0; ai < 2; ++ai)
#pragma unroll
            for (int m = 0; m < 4; ++m) { unsigned char* rowp = O + (size_t)(row0 + ai * HALF + m * 16) * ldc + col0;
#pragma unroll
                for (int bj = 0; bj < 2; ++bj) { const f32x4 v0 = acc[ai][bj][m][0] * sc, v1 = acc[ai][bj][m][1] * sc;
                    u32x2 w; w.x = pack4_fp8(v0[0], v0[1], v0[2], v0[3]); w.y = pack4_fp8(v1[0], v1[1], v1[2], v1[3]); *(u32x2*)(rowp + bj * HALF) = w; } }
    }
};
struct EpiBf16Q {
    static constexpr bool PERM = true;
    bf16_t* O; int ldc; const float* rs; const float* cs; unsigned char* C8 = nullptr;
    __device__ __forceinline__ void operator()(const f32x4 (&acc)[2][2][4][2], const Unit& u, int wr, int wc, int fr, int fq) const {
        const int row0 = u.pm * BM + wr * 64 + fr, col0 = u.pn * BM + wc * 32 + 8 * fq;
        const bool c8 = C8 != nullptr && u.pn >= 10 && u.pn < 14;
        f32x4 cv[2][2];
#pragma unroll
        for (int bj = 0; bj < 2; ++bj)
#pragma unroll
            for (int n = 0; n < 2; ++n) cv[bj][n] = *(const f32x4*)(cs + col0 + bj * HALF + 4 * n);
        float rr[2][4];
#pragma unroll
        for (int ai = 0; ai < 2; ++ai)
#pragma unroll
            for (int m = 0; m < 4; ++m) rr[ai][m] = rs[row0 + ai * HALF + m * 16];
#pragma unroll
        for (int ai = 0; ai < 2; ++ai)
#pragma unroll
            for (int m = 0; m < 4; ++m) { const int row = row0 + ai * HALF + m * 16; bf16_t* rowp = O + (size_t)row * ldc + col0; const float r = rr[ai][m];
#pragma unroll
                for (int bj = 0; bj < 2; ++bj) { const i32x4 i0 = __builtin_bit_cast(i32x4, acc[ai][bj][m][0]), i1 = __builtin_bit_cast(i32x4, acc[ai][bj][m][1]);
                    const f32x4 v0 = (f32x4){(float)i0[0], (float)i0[1], (float)i0[2], (float)i0[3]} * (cv[bj][0] * r), v1 = (f32x4){(float)i1[0], (float)i1[1], (float)i1[2], (float)i1[3]} * (cv[bj][1] * r);
                    u32x4 w; w.x = cvt_pk_bf16(v0[0], v0[1]); w.y = cvt_pk_bf16(v0[2], v0[3]); w.z = cvt_pk_bf16(v1[0], v1[1]); w.w = cvt_pk_bf16(v1[2], v1[3]);
                    *(u32x4*)(rowp + bj * HALF) = w;
                    if (c8) { u32x2 w8; w8.x = pack4_fp8(v0[0], v0[1], v0[2], v0[3]); w8.y = pack4_fp8(v1[0], v1[1], v1[2], v1[3]); *(u32x2*)(C8 + (size_t)row * 1024 + (col0 - 10 * BM) + bj * HALF) = w8; } } }
    }
};
template <bool OUT8> struct EpiGateUpQ {
    static constexpr bool PERM = true;
    void* O; int ldc; const float* rs; const float* cs;
    const int* tile_e = nullptr; int cs_stride = 0;
    int nkt = 0;
    __device__ __forceinline__ void operator()(const f32x4 (&acc)[2][2][4][2], const Unit& u, int wr, int wc, int fr, int fq) const {
        const int row0 = u.pm * BM + wr * 64 + fr, col0 = u.pn * HALF + wc * 32 + 8 * fq, c0 = u.pn * BM + wc * 32 + 8 * fq + (tile_e ? tile_e[u.pm] * cs_stride : 0);
        const f32x4 cg0 = *(const f32x4*)(cs + c0), cg1 = *(const f32x4*)(cs + c0 + 4), cu0 = *(const f32x4*)(cs + c0 + HALF), cu1 = *(const f32x4*)(cs + c0 + HALF + 4);
        float rr[2][4];
#pragma unroll
        for (int ai = 0; ai < 2; ++ai)
#pragma unroll
            for (int m = 0; m < 4; ++m) rr[ai][m] = rs[row0 + ai * HALF + m * 16];
#pragma unroll
        for (int ai = 0; ai < 2; ++ai)
#pragma unroll
            for (int m = 0; m < 4; ++m) { const int row = row0 + ai * HALF + m * 16; const size_t eo = (OUT8 && nkt) ? ((size_t)(u.pm * nkt + u.pn) * BM + (wr * 64 + fr + ai * HALF + m * 16)) * HALF + wc * 32 + 8 * fq : (size_t)row * ldc + col0; const float r = rr[ai][m];
                float h[8];
#pragma unroll
                for (int n = 0; n < 2; ++n) { const f32x4 cg = (n ? cg1 : cg0) * r, cu = (n ? cu1 : cu0) * r; const i32x4 ig = __builtin_bit_cast(i32x4, acc[ai][0][m][n]), iu = __builtin_bit_cast(i32x4, acc[ai][1][m][n]);
#pragma unroll
                    for (int q = 0; q < 2; ++q) { const f32x2 g = {(float)ig[2 * q] * cg[2 * q], (float)ig[2 * q + 1] * cg[2 * q + 1]}, up = {(float)iu[2 * q] * cu[2 * q], (float)iu[2 * q + 1] * cu[2 * q + 1]};
                        const f32x2 t = g * up, a = g * (-1.4426950408889634f); f32x2 e; e.x = __builtin_amdgcn_exp2f(a.x); e.y = __builtin_amdgcn_exp2f(a.y);
                        const f32x2 d = e + 1.0f; f32x2 rr; rr.x = __builtin_amdgcn_rcpf(d.x); rr.y = __builtin_amdgcn_rcpf(d.y);
                        const f32x2 hv = t * rr; h[n * 4 + 2 * q] = hv.x; h[n * 4 + 2 * q + 1] = hv.y; } }
                if constexpr (OUT8) { u32x2 w; w.x = pack4_fp8(h[0], h[1], h[2], h[3]); w.y = pack4_fp8(h[4], h[5], h[6], h[7]); *(u32x2*)((unsigned char*)O + eo) = w; }
                else { u32x4 w; w.x = cvt_pk_bf16(h[0], h[1]); w.y = cvt_pk_bf16(h[2], h[3]); w.z = cvt_pk_bf16(h[4], h[5]); w.w = cvt_pk_bf16(h[6], h[7]); *(u32x4*)((bf16_t*)O + eo) = w; } }
    }
};
template <bool SRC32> struct EpiResid16 {
    static constexpr bool PERM = true;
    const float* srcL; const float* srcC; bf16_t* H; const float* gateL; const float* gateC; float sc;
    __device__ __forceinline__ void operator()(const f32x4 (&acc)[2][2][4][2], const Unit& u, int wr, int wc, int fr, int fq) const {
        const bool lat = u.pm < 128;
        const float* src = lat ? srcL + (size_t)u.pm * BM * DM : srcC + (size_t)(u.pm - 128) * BM * DM;
        bf16_t* hb = H + (size_t)u.pm * BM * DM;
        const float* gate = lat ? gateL + (size_t)(u.pm >> 3) * 12288 : gateC;
        const int row0 = wr * 64 + fr, col0 = u.pn * BM + wc * 32 + 8 * fq;
        f32x4 gv[2][2];
#pragma unroll
        for (int bj = 0; bj < 2; ++bj)
#pragma unroll
            for (int n = 0; n < 2; ++n) gv[bj][n] = *(const f32x4*)(gate + col0 + bj * HALF + n * 4) * sc;
#pragma unroll
        for (int ai = 0; ai < 2; ++ai)
#pragma unroll
            for (int m = 0; m < 4; ++m) { const size_t off = (size_t)(row0 + ai * HALF + m * 16) * DM + col0;
#pragma unroll
                for (int bj = 0; bj < 2; ++bj) { f32x4 s0, s1;
                    if constexpr (SRC32) { s0 = *(const f32x4*)(src + off + bj * HALF); s1 = *(const f32x4*)(src + off + bj * HALF + 4); }
                    else { const u32x4 w = *(const u32x4*)(hb + off + bj * HALF); s0 = (f32x4){bf_lo(w.x), bf_hi(w.x), bf_lo(w.y), bf_hi(w.y)}; s1 = (f32x4){bf_lo(w.z), bf_hi(w.z), bf_lo(w.w), bf_hi(w.w)}; }
                    const f32x4 v0 = s0 + gv[bj][0] * acc[ai][bj][m][0], v1 = s1 + gv[bj][1] * acc[ai][bj][m][1];
                    u32x4 o; o.x = cvt_pk_bf16(v0[0], v0[1]); o.y = cvt_pk_bf16(v0[2], v0[3]); o.z = cvt_pk_bf16(v1[0], v1[1]); o.w = cvt_pk_bf16(v1[2], v1[3]);
                    *(u32x4*)(hb + off + bj * HALF) = o; }
                if (SRC32 && (m & 1)) asm volatile("" ::: "memory"); }
    }
};
struct EpiMoeDown {
    static constexpr bool PERM = false;
    float* h; const float* gateL; const int* rowtok; const float* roww;
    __device__ __forceinline__ void operator()(const f32x4 (&acc)[2][2][4][2], const Unit& u, int wr, int wc, int fr, int fq) const {
        const int prow0 = u.pm * BM + wr * 64 + fr, col0 = u.pn * BM + wc * 32 + 4 * fq;
#pragma unroll
        for (int ai = 0; ai < 2; ++ai)
#pragma unroll
            for (int m = 0; m < 4; ++m) { const int p = prow0 + ai * HALF + m * 16; const int tok = rowtok[p]; const float w = roww[p];
                if (tok >= 0) { float* hp = h + (size_t)tok * DM + col0; const float* gate = gateL + (size_t)(tok >> 11) * 12288 + col0;
#pragma unroll
                    for (int bj = 0; bj < 2; ++bj)
#pragma unroll
                        for (int n = 0; n < 2; ++n) { const f32x4 gv = *(const f32x4*)(gate + bj * HALF + n * 16); const f32x4 v = gv * acc[ai][bj][m][n] * w;
#pragma unroll
                            for (int j = 0; j < 4; ++j) unsafeAtomicAdd(hp + bj * HALF + n * 16 + j, v[j]); } } }
    }
};

template <class Epi, class Sched, int MODE = 0>
__device__ __forceinline__ void gemm_phase(LAS unsigned char* lds, const Gemm g, const Sched& S, const Epi& E) {
    constexpr bool FP8 = MODE == 1, I8 = MODE == 2;
    const int tid = threadIdx.x, wid = __builtin_amdgcn_readfirstlane(tid >> 6), lane = tid & 63, wr = wid >> 2, wc = wid & 3, fr = lane & 15, fq = lane >> 4;
    const int K = g.K, nt = K / BK, lda = g.lda;
    unsigned voffA[2], voffB[2];
#pragma unroll
    for (int i = 0; i < 2; ++i) { int R, C; stage_rc(tid * 16 + i * 8192, R, C); const int Rb = Epi::PERM ? ((R & ~31) + perm32(R & 31)) : R;
        voffA[i] = (unsigned)(R * lda + C) * 2u; voffB[i] = (unsigned)(Rb * K + C) * 2u; }
    const size_t kstep = (size_t)(BK * 2);
    const size_t hstepA = (size_t)HALF * lda * 2, hstepB = (size_t)HALF * K * 2;
    const size_t tstepA = g.atile ? g.atile : 2 * hstepA, kstepA = g.akstep ? g.akstep : kstep;
    const unsigned ldsw = (unsigned)wid * 1024u;
    const int aoff = lds_byte(wr * 64 + fr, fq * 8), boff = lds_byte(wc * 32 + fr, fq * 8);
#define PG8_SA(b, h) (((b) * 2 + (h)) * HTB)
#define PG8_SB(b, h) ((4 + (b) * 2 + (h)) * HTB)
#define PG8_STAGE(bufoff, gbase, voff) do { _Pragma("unroll") for (int _i = 0; _i < 2; ++_i) \
        __builtin_amdgcn_global_load_lds((const unsigned*)((const char*)(gbase) + (voff)[_i]), (LAS unsigned*)(lds + (bufoff) + ldsw + _i * 8192), 16, 0, 0); } while (0)
#define PG8_LDA(dst, b, h) do { _Pragma("unroll") for (int m = 0; m < 4; ++m) _Pragma("unroll") for (int k = 0; k < 2; ++k) dst[m][k] = *(const LAS bf16x8*)(lds + PG8_SA(b, h) + aoff + m * 2048 + k * 1024); } while (0)
#define PG8_LDB(dst, b, h) do { _Pragma("unroll") for (int n = 0; n < 2; ++n) _Pragma("unroll") for (int k = 0; k < 2; ++k) dst[n][k] = *(const LAS bf16x8*)(lds + PG8_SB(b, h) + boff + n * 2048 + k * 1024); } while (0)
#define PG8_CAT8(lo, hi) __builtin_shufflevector(__builtin_bit_cast(i32x4, lo), __builtin_bit_cast(i32x4, hi), 0, 1, 2, 3, 4, 5, 6, 7)
#define PG8_MMA(ai, bj, At, Bt) do { __builtin_amdgcn_s_setprio(1); \
        if constexpr (FP8) { _Pragma("unroll") for (int m = 0; m < 4; ++m) _Pragma("unroll") for (int n = 0; n < 2; ++n) \
            asm volatile("v_mfma_f32_16x16x128_f8f6f4 %0, %1, %2, %0" : "+v"(acc[ai][bj][m][n]) : "v"(PG8_CAT8(Bt[n][0], Bt[n][1])), "v"(PG8_CAT8(At[m][0], At[m][1]))); } \
        else if constexpr (I8) { _Pragma("unroll") for (int m = 0; m < 4; ++m) _Pragma("unroll") for (int n = 0; n < 2; ++n) _Pragma("unroll") for (int k = 0; k < 2; ++k) \
            acc[ai][bj][m][n] = __builtin_bit_cast(f32x4, __builtin_amdgcn_mfma_i32_16x16x64_i8(__builtin_bit_cast(i32x4, Bt[n][k]), __builtin_bit_cast(i32x4, At[m][k]), __builtin_bit_cast(i32x4, acc[ai][bj][m][n]), 0, 0, 0)); } \
        else { _Pragma("unroll") for (int m = 0; m < 4; ++m) _Pragma("unroll") for (int n = 0; n < 2; ++n) _Pragma("unroll") for (int k = 0; k < 2; ++k) \
            acc[ai][bj][m][n] = __builtin_amdgcn_mfma_f32_16x16x32_bf16(Bt[n][k], At[m][k], acc[ai][bj][m][n], 0, 0, 0); } \
        __builtin_amdgcn_s_setprio(0); } while (0)
#define PG8_WAIT_V(n) asm volatile("s_waitcnt vmcnt(" #n ")" ::: "memory")
#define PG8_WAIT_L(n) asm volatile("s_waitcnt lgkmcnt(" #n ")" ::: "memory")
#define PG8_BAR __builtin_amdgcn_s_barrier()
#define PG8_SCHED __builtin_amdgcn_sched_barrier(0)
    Unit cur, nxt; int ui = 0;
    if (!S.next(0, cur)) return;
#if GEMM_STAGGER
    for (int i = (int)((blockIdx.x >> 3) & 7); i > 0; --i) __builtin_amdgcn_s_sleep(GEMM_STAGGER);
#endif
    f32x4 acc[2][2][4][2];
#pragma unroll
    for (int a = 0; a < 2; ++a)
#pragma unroll
        for (int b = 0; b < 2; ++b)
#pragma unroll
            for (int m = 0; m < 4; ++m)
#pragma unroll
                for (int n = 0; n < 2; ++n) acc[a][b][m][n] = (f32x4){0.f, 0.f, 0.f, 0.f};
    bf16x8 At[4][2], B0[2][2], B1[2][2];
    const char* cA = (const char*)g.A + (size_t)cur.pm * tstepA; const char* cB = (const char*)g.Bt + S.b_row0(cur) * (size_t)K * 2;
    PG8_STAGE(PG8_SB(0, 0), cB, voffB); PG8_STAGE(PG8_SB(0, 1), cB + hstepB, voffB); PG8_STAGE(PG8_SA(0, 0), cA, voffA); PG8_STAGE(PG8_SA(0, 1), cA + hstepA, voffA);
    if (wr == 1) PG8_BAR;
    PG8_WAIT_V(2); PG8_BAR;
    PG8_STAGE(PG8_SB(1, 0), cB + kstep, voffB); PG8_STAGE(PG8_SA(1, 0), cA + kstepA, voffA); PG8_STAGE(PG8_SB(1, 1), cB + hstepB + kstep, voffB);
    PG8_WAIT_V(6); PG8_BAR;
    for (;;) {
        const bool has_next = S.next(ui + 1, nxt);
        const char* nA = has_next ? (const char*)g.A + (size_t)nxt.pm * tstepA : cA; const char* nB = has_next ? (const char*)g.Bt + S.b_row0(nxt) * (size_t)K * 2 : cB;
        for (int t = 0; t < nt; t += 2) {
            const bool last = (t == nt - 2);
            const char* a1 = cA + (size_t)(t + 1) * kstepA;
            const char* a2 = last ? nA : cA + (size_t)(t + 2) * kstepA; const char* b2 = last ? nB : cB + (size_t)(t + 2) * kstep;
            const char* a3 = a2 + kstepA; const char* b3 = b2 + kstep;
            if constexpr (FP8) asm volatile("" : "+v"(voffA[0]), "+v"(voffA[1]), "+v"(voffB[0]), "+v"(voffB[1]));
            PG8_LDB(B0, 0, 0); PG8_LDB(B1, 0, 1); PG8_SCHED; PG8_LDA(At, 0, 0); PG8_STAGE(PG8_SA(1, 1), a1 + hstepA, voffA);
            PG8_WAIT_V(8); PG8_WAIT_L(0); PG8_BAR; PG8_MMA(0, 0, At, B0); PG8_MMA(0, 1, At, B1); PG8_BAR; PG8_SCHED;
            PG8_LDA(At, 0, 1); PG8_STAGE(PG8_SB(0, 0), b2, voffB); PG8_STAGE(PG8_SB(0, 1), b2 + hstepB, voffB); PG8_STAGE(PG8_SA(0, 0), a2, voffA);
            PG8_WAIT_V(8); PG8_WAIT_L(0); PG8_BAR; PG8_MMA(1, 0, At, B0); PG8_MMA(1, 1, At, B1); PG8_BAR; PG8_SCHED;
            PG8_LDB(B0, 1, 0); PG8_LDB(B1, 1, 1); PG8_SCHED; PG8_LDA(At, 1, 0); PG8_STAGE(PG8_SA(0, 1), a2 + hstepA, voffA);
            PG8_WAIT_V(8); PG8_WAIT_L(0); PG8_BAR; PG8_MMA(0, 0, At, B0); PG8_MMA(0, 1, At, B1); PG8_BAR; PG8_SCHED;
            PG8_LDA(At, 1, 1); PG8_STAGE(PG8_SB(1, 0), b3, voffB); PG8_STAGE(PG8_SB(1, 1), b3 + hstepB, voffB); PG8_STAGE(PG8_SA(1, 0), a3, voffA);
            PG8_WAIT_V(8); PG8_WAIT_L(0); PG8_BAR; PG8_MMA(1, 0, At, B0); PG8_MMA(1, 1, At, B1); PG8_BAR; PG8_SCHED;
        }
        if (wr == 0) PG8_BAR;
        if constexpr (FP8) asm volatile("s_nop 15\n\ts_nop 15" ::: "memory");
        E(acc, cur, wr, wc, fr, fq);
        if (!has_next) break;
#pragma unroll
        for (int a = 0; a < 2; ++a)
#pragma unroll
            for (int b = 0; b < 2; ++b)
#pragma unroll
                for (int m = 0; m < 4; ++m)
#pragma unroll
                    for (int n = 0; n < 2; ++n) acc[a][b][m][n] = (f32x4){0.f, 0.f, 0.f, 0.f};
        cur = nxt; cA = nA; cB = nB; ++ui;
        if (wr == 1) PG8_BAR;
    }
    PG8_WAIT_V(0);
    PG8_BAR;
#undef PG8_SA
#undef PG8_SB
#undef PG8_STAGE
#undef PG8_LDA
#undef PG8_LDB
#undef PG8_MMA
#undef PG8_CAT8
#undef PG8_WAIT_V
#undef PG8_WAIT_L
#undef PG8_BAR
#undef PG8_SCHED
}
}

constexpr int RING_BYTES = 131072;
constexpr int LDSCTL_OFF = 147456;
constexpr int LDS_BYTES = 155648;
constexpr int NWAVES = 8, NTHR = 512;

struct Args { const float* in[31]; float* out; unsigned char* ws; int ph_lo, ph_hi; };
struct Frame {
    LAS unsigned char* lds;
    int tid, lane, wave, G, bid;
    const float* const* in;
    float* out; unsigned char* ws;
};
#define WSP(T, off) ((T*)(F.ws + (off)))

__device__ __forceinline__ int col_map(int kind, int n) {
    switch (kind) {
        case 1: {
            if (n < 2048) return n;
            if (n < 2072) return PDT + (n - 2048);
            if (n < 2584) return PPOOL + (n - 2072);
            if (n < 3096) return PCQ + (n - 2584);
            if (n < 3608) return PCKV + (n - 3096);
            return PKR + (n - 3608); }
        case 2: { const int h = n >> 8, j = n & 255; return h * 320 + (j < 128 ? j : 192 + (j - 128)); }
        case 3: return (n >> 7) * 256 + (n & 127);
        case 4: return (n >> 7) * 256 + 128 + (n & 127);
        default: return n;
    }
}
template <bool OUT8 = false>
__device__ __forceinline__ void tr_item(const float* W, int K, int N, bf16_t* WT, int kind, const float* kscale, LAS float* scr, int item, int lane) {
    const int nblk = (N + 31) / 32, kb = item / nblk, nb = item % nblk, k0 = 64 * kb, n0 = 32 * nb;
    const int n4 = n0 + (lane & 7) * 4, kr = lane >> 3; const bool nok = n4 < N;
    f32x4 v[8];
#pragma unroll
    for (int i = 0; i < 8; ++i) v[i] = nok ? *(const f32x4*)(W + (size_t)(k0 + kr + 8 * i) * N + n4) : (f32x4){0.f, 0.f, 0.f, 0.f};
#pragma unroll
    for (int i = 0; i < 8; ++i) { const int kk = kr + 8 * i; f32x4 x = v[i]; if (kscale) x = x * kscale[k0 + kk];
        LAS float* d = scr + kk * 33 + (lane & 7) * 4; d[0] = x[0]; d[1] = x[1]; d[2] = x[2]; d[3] = x[3]; }
    LDS_WAIT(); asm volatile("" ::: "memory");
    const int c = lane & 7;
#pragma unroll
    for (int j = 0; j < 4; ++j) { const int n = (lane >> 3) + 8 * j; const LAS float* s = scr + (8 * c) * 33 + n;
        if constexpr (OUT8) { u32x2 o; o.x = pack4_fp8(s[0 * 33] * W8_SCALE, s[1 * 33] * W8_SCALE, s[2 * 33] * W8_SCALE, s[3 * 33] * W8_SCALE); o.y = pack4_fp8(s[4 * 33] * W8_SCALE, s[5 * 33] * W8_SCALE, s[6 * 33] * W8_SCALE, s[7 * 33] * W8_SCALE);
            if (n0 + n < N) *(u32x2*)((unsigned char*)WT + (size_t)col_map(kind, n0 + n) * K + k0 + 8 * c) = o; }
        else { u32x4 o; o.x = cvt_pk_bf16(s[0 * 33], s[1 * 33]); o.y = cvt_pk_bf16(s[2 * 33], s[3 * 33]); o.z = cvt_pk_bf16(s[4 * 33], s[5 * 33]); o.w = cvt_pk_bf16(s[6 * 33], s[7 * 33]);
            if (n0 + n < N) *(u32x4*)(WT + (size_t)col_map(kind, n0 + n) * K + k0 + 8 * c) = o; } }
    LDS_WAIT(); asm volatile("" ::: "memory");
}
__device__ __forceinline__ void tr_item8(const float* W, int K, int N, unsigned char* WT, int kind, LAS float* scr, int item, int lane, const float* kscale = nullptr) {
    const int nblk = (N + 31) / 32, kb = item / nblk, nb = item % nblk, k0 = 128 * kb, n0 = 32 * nb;
    const int n4 = n0 + (lane & 7) * 4, kr = lane >> 3; const bool nok = n4 < N;
    f32x4 v[16];
#pragma unroll
    for (int i = 0; i < 16; ++i) v[i] = nok ? *(const f32x4*)(W + (size_t)(k0 + kr + 8 * i) * N + n4) : (f32x4){0.f, 0.f, 0.f, 0.f};
#pragma unroll
    for (int i = 0; i < 16; ++i) { LAS float* d = scr + (kr + 8 * i) * 33 + (lane & 7) * 4; const float ks = kscale ? kscale[k0 + kr + 8 * i] * W8_SCALE : W8_SCALE; d[0] = v[i][0] * ks; d[1] = v[i][1] * ks; d[2] = v[i][2] * ks; d[3] = v[i][3] * ks; }
    LDS_WAIT(); asm volatile("" ::: "memory");
    const int c = lane & 7;
#pragma unroll
    for (int j = 0; j < 4; ++j) { const int n = (lane >> 3) + 8 * j; const LAS float* s = scr + (16 * c) * 33 + n;
        u32x4 o; o.x = pack4_fp8(s[0 * 33], s[1 * 33], s[2 * 33], s[3 * 33]); o.y = pack4_fp8(s[4 * 33], s[5 * 33], s[6 * 33], s[7 * 33]);
        o.z = pack4_fp8(s[8 * 33], s[9 * 33], s[10 * 33], s[11 * 33]); o.w = pack4_fp8(s[12 * 33], s[13 * 33], s[14 * 33], s[15 * 33]);
        if (n0 + n < N) *(u32x4*)(WT + (size_t)col_map(kind, n0 + n) * K + k0 + 16 * c) = o; }
    LDS_WAIT(); asm volatile("" ::: "memory");
}
__device__ __forceinline__ void tr_itemq(const float* W, int K, int N, unsigned char* WT, int kind, const float* cs, LAS float* scr, int item, int lane) {
    const int nblk = (N + 31) / 32, kb = item / nblk, nb = item % nblk, k0 = 128 * kb, n0 = 32 * nb;
    const int n4 = n0 + (lane & 7) * 4, kr = lane >> 3; const bool nok = n4 < N;
    f32x4 v[16];
#pragma unroll
    for (int i = 0; i < 16; ++i) v[i] = nok ? *(const f32x4*)(W + (size_t)(k0 + kr + 8 * i) * N + n4) : (f32x4){0.f, 0.f, 0.f, 0.f};
#pragma unroll
    for (int i = 0; i < 16; ++i) { LAS float* d = scr + (kr + 8 * i) * 33 + (lane & 7) * 4; d[0] = v[i][0]; d[1] = v[i][1]; d[2] = v[i][2]; d[3] = v[i][3]; }
    LDS_WAIT(); asm volatile("" ::: "memory");
    const int c = lane & 7;
#pragma unroll
    for (int j = 0; j < 4; ++j) { const int n = (lane >> 3) + 8 * j; const LAS float* sp = scr + (16 * c) * 33 + n;
        if (n0 + n < N) { const int drow = col_map(kind, n0 + n); const float inv = 1.0f / cs[drow];
            u32x4 o; o.x = pack4_i8(sp[0 * 33] * inv, sp[1 * 33] * inv, sp[2 * 33] * inv, sp[3 * 33] * inv); o.y = pack4_i8(sp[4 * 33] * inv, sp[5 * 33] * inv, sp[6 * 33] * inv, sp[7 * 33] * inv);
            o.z = pack4_i8(sp[8 * 33] * inv, sp[9 * 33] * inv, sp[10 * 33] * inv, sp[11 * 33] * inv); o.w = pack4_i8(sp[12 * 33] * inv, sp[13 * 33] * inv, sp[14 * 33] * inv, sp[15 * 33] * inv);
            *(u32x4*)(WT + (size_t)drow * K + k0 + 16 * c) = o; } }
    LDS_WAIT(); asm volatile("" ::: "memory");
}
__device__ __forceinline__ void col_scale_pass(const float* W, int K, int N, int kind, float* cs, long gthread, long nthreads) {
    for (long t = gthread; t < 2L * N; t += nthreads) { const int n = (int)(t >> 1), par = (int)(t & 1); float mx = 0.f;
        for (int k0 = par * 16; k0 < K; k0 += 512) { float v[16];
#pragma unroll
            for (int i = 0; i < 16; ++i) { const int k = k0 + 32 * i; v[i] = k < K ? fabsf(W[(size_t)k * N + n]) : 0.f; }
#pragma unroll
            for (int i = 0; i < 16; ++i) mx = fmaxf(mx, v[i]); }
        mx = fmaxf(mx, __shfl_xor(mx, 1));
        if (par == 0) cs[col_map(kind, n)] = fmaxf(mx, 1e-30f) * (1.35f / 127.0f); }
}
__device__ __forceinline__ void zero_rows(bf16_t* WT, int K, int r0, int r1, int gthread, int nthreads) {
    const long n16 = (long)(r1 - r0) * K / 8; u32x4 z = {0u, 0u, 0u, 0u};
    for (long i = gthread; i < n16; i += nthreads) *(u32x4*)(WT + (size_t)r0 * K + i * 8) = z;
}
constexpr int MOE_I_GU = FP8_MOE_GU ? 16 * 176 : 32 * 176, MOE_I_DN = FP8_MOE_DN ? 44 * 64 : 88 * 64, MOE_I_EXP = 2 * MOE_I_GU + MOE_I_DN, MOE_I_ALL = 8 * MOE_I_EXP;
__device__ __forceinline__ void moe_weight_items(Frame& F, int pct_lo, int pct_hi, int lw, int nlw) {
    LAS float* scr = (LAS float*)(F.lds + F.wave * 16896);
    const int lo = (int)((long)MOE_I_ALL * pct_lo / 100), hi = (int)((long)MOE_I_ALL * pct_hi / 100);
    for (int it = lo + lw; it < hi; it += nlw) {
        int r = it; const int e = r / MOE_I_EXP; r -= e * MOE_I_EXP;
        unsigned char* gu = F.ws + WS_MWGU + (size_t)e * 11264 * 2048 * (FP8_MOE_GU ? 1 : 2); unsigned char* dn = F.ws + WS_MWDN + (size_t)e * 2048 * FF * (FP8_MOE_DN ? 1 : 2);
        if (r < 2 * MOE_I_GU) { const int up = r >= MOE_I_GU; r -= up * MOE_I_GU; const float* W = F.in[28 + up] + (size_t)e * 2048 * FF;
            if constexpr (I8_MOE_GU != 0) tr_itemq(W, 2048, FF, gu, 3 + up, WSP(float, WS_SMALL + SM_CS_MGU) + e * 11264, scr, r, F.lane);
            else if constexpr (FP8_MOE_GU != 0) tr_item8(W, 2048, FF, gu, 3 + up, scr, r, F.lane); else tr_item(W, 2048, FF, (bf16_t*)gu, 3 + up, nullptr, scr, r, F.lane); continue; }
        r -= 2 * MOE_I_GU;
        if constexpr (FP8_MOE_DN != 0) tr_item8(F.in[30] + (size_t)e * FF * 2048, FF, 2048, dn, 0, scr, r, F.lane); else tr_item(F.in[30] + (size_t)e * FF * 2048, FF, 2048, (bf16_t*)dn, 0, nullptr, scr, r, F.lane);
    }
}
__device__ __forceinline__ void win_i8_items(Frame& F, int l, int lw, int nlw) {
    LAS float* scr = (LAS float*)(F.lds + F.wave * 16896);
    for (int it = lw; it < 16 * 115; it += nlw) tr_itemq(F.in[8] + (size_t)l * 2048 * D_IN, 2048, D_IN, F.ws + WS_WIN + (size_t)l * PC * 2048 * 2, 1, WSP(float, WS_SMALL + SM_CS_WIN) + l * PC, scr, it, F.lane);
}
__device__ __forceinline__ void p0_prologue(Frame& F) {
    const int gw = F.bid * NWAVES + F.wave, NGW = F.G * NWAVES, gthr = F.bid * NTHR + F.tid, nthr = F.G * NTHR;
    {
        LAS float* s = (LAS float*)F.lds;
        LAS float* red = (LAS float*)(F.lds + 17 * 1024 * 4);
        const int c4 = (F.lane & 31) * 4, slice = F.wave * 2 + (F.lane >> 5);
        for (int u = F.bid; u < 192; u += F.G) {
            const int l = u / 96, n0 = (u % 96) * 128;
            f32x4 acc[17];
#pragma unroll
            for (int b = 0; b < 17; ++b) acc[b] = (f32x4){0.f, 0.f, 0.f, 0.f};
            for (int hf = 0; hf < 2; ++hf) {
                __syncthreads();
                for (int i = F.tid; i < 17 * 1024; i += NTHR) { const int b = i >> 10, k = (i & 1023) + hf * 1024; const float v = b < 16 ? F.in[1][b * 2048 + k] : F.in[3][k]; s[i] = silu_f(v); }
                __syncthreads();
                const float* W = F.in[4] + (size_t)l * 2048 * 12288 + (size_t)(hf * 1024 + slice * 64) * 12288 + n0 + c4;
                for (int k = 0; k < 64; k += 16) { f32x4 wv[16];
#pragma unroll
                    for (int kk = 0; kk < 16; ++kk) wv[kk] = *(const f32x4*)(W + (size_t)(k + kk) * 12288);
#pragma unroll
                    for (int b = 0; b < 17; ++b) {
#pragma unroll
                        for (int q4 = 0; q4 < 4; ++q4) { const f32x4 sv = *(const LAS f32x4*)(s + b * 1024 + slice * 64 + k + 4 * q4);
                            acc[b] += (wv[4 * q4] * sv[0] + wv[4 * q4 + 1] * sv[1]) + (wv[4 * q4 + 2] * sv[2] + wv[4 * q4 + 3] * sv[3]); } } }
            }
            __syncthreads();
#pragma unroll
            for (int b = 0; b < 17; ++b) { f32x4 t = acc[b];
                t[0] += __shfl_xor(t[0], 32); t[1] += __shfl_xor(t[1], 32); t[2] += __shfl_xor(t[2], 32); t[3] += __shfl_xor(t[3], 32);
                if (F.lane < 32) *(LAS f32x4*)(red + (F.wave * 17 + b) * 128 + c4) = t; }
            __syncthreads();
            for (int i = F.tid; i < 17 * 128; i += NTHR) { const int b = i >> 7, cl = i & 127, nn = n0 + cl;
                float sum = F.in[5][l * 12288 + nn];
#pragma unroll
                for (int q2 = 0; q2 < 8; ++q2) sum += red[(q2 * 17 + b) * 128 + cl];
                if (b < 16) WSP(float, WS_SMALL + SM_MODL)[((size_t)l * 16 + b) * 12288 + nn] = sum; else WSP(float, WS_SMALL + SM_MODC)[(size_t)l * 12288 + nn] = sum; }
        }
        __syncthreads();
    }
    {
        LAS float* scr = (LAS float*)(F.lds + F.wave * 16896);
        constexpr int I_WIN = 32 * 115, I_WIN8 = 16 * 115, I_UQ = 8 * 36, I_UKV = 8 * 48, I_WOUT = 32 * 64;
        constexpr int I_WIN_L0 = (I8_INPROJ & 1) ? 0 : I_WIN, I_WIN_L1 = (I8_INPROJ & 2) ? 0 : (FP8_INPROJ_L1 ? I_WIN8 : I_WIN);
        constexpr int I_L0 = I_WIN_L0 + I_UQ + I_UKV + I_WOUT, I_L1 = I_WIN_L1 + I_UQ + I_UKV + I_WOUT;
        constexpr int I_GU16 = 32 * 176, I_DN16 = 88 * 64, I_GU8 = 16 * 176, I_DN8 = 44 * 64;
        constexpr int I_DGU = I8_DENSE_GU ? 0 : (FP8_DENSE_GU ? I_GU8 : I_GU16), I_DDN = FP8_DENSE_DN ? I_DN8 : I_DN16;
        constexpr int I_DENSE = 2 * I_DGU + I_DDN;
        constexpr int NITEMS = I_L0 + I_L1 + I_DENSE;
        for (int it = gw; it < NITEMS; it += NGW) {
            int r = it;
            if (r < I_DENSE) {
                if (r < 2 * I_DGU) { const int up = r >= I_DGU; r -= up * I_DGU;
                    if constexpr (FP8_DENSE_GU != 0) tr_item8(F.in[24 + up], 2048, FF, F.ws + WS_WGU, 3 + up, scr, r, F.lane); else tr_item(F.in[24 + up], 2048, FF, WSP(bf16_t, WS_WGU), 3 + up, nullptr, scr, r, F.lane); continue; }
                r -= 2 * I_DGU;
                if constexpr (FP8_DENSE_DN != 0) tr_item8(F.in[26], FF, 2048, F.ws + WS_WDN, 0, scr, r, F.lane); else tr_item(F.in[26], FF, 2048, WSP(bf16_t, WS_WDN), 0, nullptr, scr, r, F.lane);
                continue; }
            r -= I_DENSE;
            { const int l = r >= I_L0 ? 1 : 0; r -= l * I_L0; const int iwin = l ? I_WIN_L1 : I_WIN_L0;
                if (r < iwin) { if (l == 1 && FP8_INPROJ_L1) tr_item8(F.in[8] + (size_t)l * 2048 * D_IN, 2048, D_IN, F.ws + WS_WIN + (size_t)l * PC * 2048 * 2, 1, scr, r, F.lane);
                                else tr_item(F.in[8] + (size_t)l * 2048 * D_IN, 2048, D_IN, WSP(bf16_t, WS_WIN) + (size_t)l * PC * 2048, 1, nullptr, scr, r, F.lane); continue; } r -= iwin;
                if (r < I_UQ) { if constexpr (FP8_UQKV != 0) { if (r < 4 * 36) tr_item8(F.in[18] + (size_t)l * 512 * 1152, 512, 1152, F.ws + WS_WUQ + (size_t)l * QC * 512 * 2, 0, scr, r, F.lane, F.in[17] + l * 512); }
                                else tr_item(F.in[18] + (size_t)l * 512 * 1152, 512, 1152, WSP(bf16_t, WS_WUQ) + (size_t)l * QC * 512, 0, F.in[17] + l * 512, scr, r, F.lane); continue; } r -= I_UQ;
                if (r < I_UKV) { if constexpr (FP8_UQKV != 0) { if (r < 4 * 48) tr_item8(F.in[20] + (size_t)l * 512 * 1536, 512, 1536, F.ws + WS_WUKV + (size_t)l * KVC * 512 * 2, 2, scr, r, F.lane, F.in[19] + l * 512); }
                                 else tr_item(F.in[20] + (size_t)l * 512 * 1536, 512, 1536, WSP(bf16_t, WS_WUKV) + (size_t)l * KVC * 512, 2, F.in[19] + l * 512, scr, r, F.lane); continue; } r -= I_UKV;
                if ((FP8_WOUT >> l) & 1) { if (r < 16 * 64) tr_item8(F.in[23] + (size_t)l * 2048 * 2048, 2048, 2048, F.ws + WS_WOUT + (size_t)l * 2048 * 2048 * 2, 0, scr, r, F.lane); }
                else tr_item(F.in[23] + (size_t)l * 2048 * 2048, 2048, 2048, WSP(bf16_t, WS_WOUT) + (size_t)l * 2048 * 2048, 0, nullptr, scr, r, F.lane); }
        }
    }
    {
        constexpr long NC_MOE = I8_MOE_GU ? 16L * FF : 0, NC_DGU = I8_DENSE_GU ? 2L * FF : 0, NC_WIN = ((I8_INPROJ & 1) ? D_IN : 0) + ((I8_INPROJ & 2) ? D_IN : 0);
        for (long t = gthr; t < 2 * (NC_MOE + NC_DGU + NC_WIN); t += nthr) { long c = t >> 1; const int par = (int)(t & 1);
            const float* W; int N, n, kind; float* cs;
            if (c < NC_MOE) { const int mat = (int)(c / FF), e = mat >> 1, up = mat & 1; n = (int)(c % FF); N = FF; kind = 3 + up; W = F.in[28 + up] + (size_t)e * 2048 * FF; cs = WSP(float, WS_SMALL + SM_CS_MGU) + e * 11264; }
            else if ((c -= NC_MOE) < NC_DGU) { const int up = (int)(c / FF); n = (int)(c % FF); N = FF; kind = 3 + up; W = F.in[24 + up]; cs = WSP(float, WS_SMALL + SM_CS_DGU); }
            else { c -= NC_DGU; int l = (int)(c / D_IN); n = (int)(c % D_IN); if ((I8_INPROJ & 3) == 2) l = 1; N = D_IN; kind = 1; W = F.in[8] + (size_t)l * 2048 * D_IN; cs = WSP(float, WS_SMALL + SM_CS_WIN) + l * PC; }
            float mx = 0.f;
            for (int k0 = par * 16; k0 < 2048; k0 += 512) { float v[16];
#pragma unroll
                for (int i2 = 0; i2 < 16; ++i2) v[i2] = fabsf(W[(size_t)(k0 + 32 * i2) * N + n]);
#pragma unroll
                for (int i2 = 0; i2 < 16; ++i2) mx = fmaxf(mx, v[i2]); }
            mx = fmaxf(mx, __shfl_xor(mx, 1));
            if (par == 0) cs[col_map(kind, n)] = fmaxf(mx, 1e-30f) * (1.35f / 127.0f); }
        for (int l = 0; l < 2; ++l) if ((I8_INPROJ >> l) & 1) { float* csw = WSP(float, WS_SMALL + SM_CS_WIN) + l * PC; for (long i2 = gthr; i2 < PC - D_IN; i2 += nthr) csw[D_IN + i2] = 1.0f; }
    }
    for (int l = 0; l < 2; ++l) {
        zero_rows(WSP(bf16_t, WS_WIN) + (size_t)l * PC * 2048, ((l == 1 && FP8_INPROJ_L1) || ((I8_INPROJ >> l) & 1)) ? 1024 : 2048, D_IN, PC, gthr, nthr);
        constexpr int KZ = FP8_UQKV ? 256 : 512;
        zero_rows(WSP(bf16_t, WS_WUQ) + (size_t)l * QC * 512, KZ, 1152, QC, gthr, nthr);
        for (int h = 0; h < 6; ++h) zero_rows(WSP(bf16_t, WS_WUKV) + (size_t)l * KVC * 512, KZ, h * 320 + 128, h * 320 + 192, gthr, nthr);
        zero_rows(WSP(bf16_t, WS_WUKV) + (size_t)l * KVC * 512, KZ, 1920, KVC, gthr, nthr);
    }
    for (int i = gthr; i < 2 * 512 * 512; i += nthr) { const int l = i >> 18, dg = (i >> 9) & 511, cg = i & 511; const int g = dg >> 7, d = dg & 127;
        float v = 0.f; if ((cg >> 7) == g) v = F.in[15][((size_t)(l * 4 + g) * 128 + (cg & 127)) * 128 + d] * F.in[16][l * 512 + dg];
        WSP(bf16_t, WS_SMALL + SM_POOLB)[i] = f2bf(v); }
    for (int i = gthr; i < 64 * 16; i += nthr) { const int pos = i >> 4, j = i & 15; const float inv = exp2f(-(float)j * (13.287712379549449f / 16.0f)); const float ang = (float)pos * inv;
        const float kf = rintf(ang * 0.15915494309189535f); float r = fmaf(-kf, 6.2831854820251465f, ang); r = fmaf(-kf, -1.7484555e-07f, r);
        WSP(float, WS_SMALL + SM_ROPE)[i * 2] = cosf(r); WSP(float, WS_SMALL + SM_ROPE)[i * 2 + 1] = sinf(r); }
}

template <bool ROUTER, int OUTM = 0, bool IN16 = false>
__device__ __forceinline__ void phase_norm(Frame& F, const float* hL, const float* hC, const float* nw, int layer, int shift_idx, int nrows) {
    const int gw = F.bid * NWAVES + F.wave, NGW = F.G * NWAVES;
    const float* modL = WSP(float, WS_SMALL + SM_MODL) + (size_t)layer * 16 * 12288;
    const float* modC = WSP(float, WS_SMALL + SM_MODC) + (size_t)layer * 12288;
    bf16_t* U = WSP(bf16_t, WS_U);
    LAS float* wr = (LAS float*)F.lds;
    if constexpr (ROUTER) { for (int i = F.tid; i < 2048 * 8; i += NTHR) wr[i] = F.in[27][i]; __syncthreads(); }
    int ecnt[8];
#pragma unroll
    for (int e = 0; e < 8; ++e) ecnt[e] = 0;
    for (int r = gw; r < nrows; r += NGW) {
        const bool lat = r < TL;
        const float* hrow = lat ? hL + (size_t)r * DM : hC + (size_t)(r - TL) * DM;
        const float* mod = lat ? modL + (size_t)(r >> 11) * 12288 : modC;
        const f32x4* xr = (const f32x4*)hrow + F.lane; const u32x2* xr16 = (const u32x2*)(WSP(bf16_t, WS_H16) + (size_t)r * DM) + F.lane;
        f32x4 v[8]; float ss = 0.f;
#pragma unroll
        for (int j = 0; j < 8; ++j) { if constexpr (IN16) { const u32x2 w = xr16[64 * j]; v[j] = (f32x4){bf_lo(w.x), bf_hi(w.x), bf_lo(w.y), bf_hi(w.y)}; } else v[j] = xr[64 * j];
            ss += (v[j][0] * v[j][0] + v[j][1] * v[j][1]) + (v[j][2] * v[j][2] + v[j][3] * v[j][3]); }
        const float rstd = rsqrtf(wave_sum(ss) * (1.0f / DM) + EPS);
        u32x2* o8 = (u32x2*)(U + (size_t)r * DM) + F.lane;
#pragma unroll
        for (int j = 0; j < 8; ++j) {
            const f32x4 w4 = *((const f32x4*)nw + F.lane + 64 * j), sh = *((const f32x4*)(mod + shift_idx * DM) + F.lane + 64 * j), sc = *((const f32x4*)(mod + (shift_idx + 1) * DM) + F.lane + 64 * j);
            v[j] = (v[j] * rstd * w4) * (sc + 1.0f) + sh;
            if constexpr (OUTM == 1) ((unsigned*)((unsigned char*)U + (size_t)r * DM))[F.lane + 64 * j] = pack4_fp8(v[j][0], v[j][1], v[j][2], v[j][3]);
            else if constexpr (OUTM == 0) { u32x2 w; w.x = cvt_pk_bf16(v[j][0], v[j][1]); w.y = cvt_pk_bf16(v[j][2], v[j][3]); o8[64 * j] = w; }
        }
        if constexpr (OUTM == 2) {
            float am = 0.f;
#pragma unroll
            for (int j = 0; j < 8; ++j) am = fmaxf(am, fmaxf(fmaxf(fabsf(v[j][0]), fabsf(v[j][1])), fmaxf(fabsf(v[j][2]), fabsf(v[j][3]))));
#pragma unroll
            for (int o = 1; o < 64; o <<= 1) am = fmaxf(am, __shfl_xor(am, o));
            am = fmaxf(am, 1e-30f); const float inv = 127.0f / am;
#pragma unroll
            for (int j = 0; j < 8; ++j) ((float*)((unsigned char*)U + (size_t)r * DM))[F.lane + 64 * j] = __uint_as_float(pack4_i8(v[j][0] * inv, v[j][1] * inv, v[j][2] * inv, v[j][3] * inv));
            if (F.lane == 0) WSP(float, WS_SMALL + SM_RS)[r] = am * (1.0f / 127.0f);
        }
        if constexpr (ROUTER) {
            float lg[8];
#pragma unroll
            for (int e = 0; e < 8; ++e) lg[e] = 0.f;
#pragma unroll
            for (int j = 0; j < 8; ++j) { asm volatile("" ::: "memory");
#pragma unroll
                for (int i = 0; i < 4; ++i) { const int idx = 256 * j + 4 * F.lane + i; const f32x4 wa = *(const LAS f32x4*)(wr + idx * 8), wb = *(const LAS f32x4*)(wr + idx * 8 + 4); const float x = v[j][i];
                    lg[0] += x * wa[0]; lg[1] += x * wa[1]; lg[2] += x * wa[2]; lg[3] += x * wa[3]; lg[4] += x * wb[0]; lg[5] += x * wb[1]; lg[6] += x * wb[2]; lg[7] += x * wb[3]; } }
#pragma unroll
            for (int e = 0; e < 8; ++e) lg[e] = wave_sum(lg[e]);
            int i1 = 0; float v1 = lg[0];
#pragma unroll
            for (int e = 1; e < 8; ++e) if (lg[e] > v1) { v1 = lg[e]; i1 = e; }
            int i2 = -1; float v2 = -3.0e38f;
#pragma unroll
            for (int e = 0; e < 8; ++e) if (e != i1 && lg[e] > v2) { v2 = lg[e]; i2 = e; }
            const float ex = __expf(v2 - v1), g1 = 1.0f / (1.0f + ex), g2 = ex * g1;
#pragma unroll
            for (int e = 0; e < 8; ++e) ecnt[e] += (i1 == e) + (i2 == e);
            if (F.lane == 0) { int* ti = WSP(int, WS_SMALL + SM_TOPI) + (size_t)r * 2; float* tw = WSP(float, WS_SMALL + SM_TOPW) + (size_t)r * 2; ti[0] = i1; ti[1] = i2; tw[0] = g1; tw[1] = g2; }
        }
    }
    if constexpr (ROUTER) { if (F.lane == 0) { int* cw = WSP(int, WS_SMALL + SM_CNTW) + (size_t)gw * 8;
#pragma unroll
            for (int e = 0; e < 8; ++e) cw[e] = ecnt[e]; }
        __syncthreads(); }
}

__device__ __forceinline__ void unpack8(const u32x4 w, float (&x)[8]) { x[0] = bf_lo(w.x); x[1] = bf_hi(w.x); x[2] = bf_lo(w.y); x[3] = bf_hi(w.y); x[4] = bf_lo(w.z); x[5] = bf_hi(w.z); x[6] = bf_lo(w.w); x[7] = bf_hi(w.w); }
__device__ __forceinline__ u32x4 pack8(const float (&x)[8]) { u32x4 w; w.x = cvt_pk_bf16(x[0], x[1]); w.y = cvt_pk_bf16(x[2], x[3]); w.z = cvt_pk_bf16(x[4], x[5]); w.w = cvt_pk_bf16(x[6], x[7]); return w; }
__device__ __forceinline__ void phase_conv_pool(Frame& F, int layer) {
    const long gthr = (long)F.bid * NTHR + F.tid, nthr = (long)F.G * NTHR;
    const bf16_t* P = WSP(bf16_t, WS_P); bf16_t* XA = WSP(bf16_t, WS_XA); bf16_t* PL = WSP(bf16_t, WS_PL); float* DT = WSP(float, WS_SMALL + SM_DT);
    const float* cw = F.in[9] + (size_t)layer * 4 * XAC; const float* cb = F.in[10] + (size_t)layer * XAC; const float* dtb = F.in[11] + layer * 24;
    constexpr long NCONV = (long)(TT / 16) * 160, NPOOL = (long)(TT / 16) * 64;
    for (long it = gthr; it < NCONV + NPOOL; it += nthr) {
      if (it < NCONV) {
        const int r0 = (TT / 16 - 1 - (int)(it / 160)) * 16, ch = (int)(it % 160) * 8;
        const int t0 = r0 < TL ? (r0 & 2047) : ((r0 - TL) & 255), n = r0 < TL ? SEQ : CTXL;
        float w[4][8], bs[8];
#pragma unroll
        for (int k = 0; k < 4; ++k) { const f32x4 a = *(const f32x4*)(cw + k * XAC + ch), b = *(const f32x4*)(cw + k * XAC + ch + 4); w[k][0] = a[0]; w[k][1] = a[1]; w[k][2] = a[2]; w[k][3] = a[3]; w[k][4] = b[0]; w[k][5] = b[1]; w[k][6] = b[2]; w[k][7] = b[3]; }
        { const f32x4 a = *(const f32x4*)(cb + ch), b = *(const f32x4*)(cb + ch + 4); bs[0] = a[0]; bs[1] = a[1]; bs[2] = a[2]; bs[3] = a[3]; bs[4] = b[0]; bs[5] = b[1]; bs[6] = b[2]; bs[7] = b[3]; }
        const bf16_t* src = P + (size_t)r0 * PC + PXBC + ch;
        u32x4 raw[19];
#pragma unroll
        for (int i = 0; i < 19; ++i) { const int tt = t0 - 2 + i; raw[i] = (tt >= 0 && tt < n) ? *(const u32x4*)(src + (long)(i - 2) * PC) : (u32x4){0u, 0u, 0u, 0u}; }
        float x0[8], x1[8], x2[8], x3[8];
        unpack8(raw[0], x0); unpack8(raw[1], x1); unpack8(raw[2], x2);
#pragma unroll
        for (int i = 0; i < 16; ++i) { unpack8(raw[i + 3], x3); float acc[8];
#pragma unroll
            for (int e = 0; e < 8; ++e) { acc[e] = bs[e] + w[0][e] * x0[e] + w[1][e] * x1[e] + w[2][e] * x2[e] + w[3][e] * x3[e]; acc[e] = silu_f(acc[e]); x0[e] = x1[e]; x1[e] = x2[e]; x2[e] = x3[e]; }
            *(u32x4*)(XA + (size_t)(r0 + i) * XAC + ch) = pack8(acc); }
      } else {
        const long ip = it - NCONV;
        const int r0 = (TT / 16 - 1 - (int)(ip >> 6)) * 16, ck = (int)(ip & 63), ch = ck * 8, w = 2 << (ck >> 4), hw = w >> 1;
        const int t0 = r0 < TL ? (r0 & 2047) : ((r0 - TL) & 255), n = r0 < TL ? SEQ : CTXL;
        const bf16_t* src = P + (size_t)(r0 - t0) * PC + PPOOL + ch;
        int lo = t0 - hw, hi = lo + w; lo = lo < 0 ? 0 : lo; hi = hi > n ? n : hi;
        float sm[8];
#pragma unroll
        for (int e = 0; e < 8; ++e) sm[e] = 0.f;
        for (int tt = lo; tt < hi; ++tt) { float x[8]; unpack8(*(const u32x4*)(src + (size_t)tt * PC), x);
#pragma unroll
            for (int e = 0; e < 8; ++e) sm[e] += x[e]; }
#pragma unroll 4
        for (int i = 0; i < 16; ++i) { const int t = t0 + i; float u[8], o[8]; unpack8(*(const u32x4*)(src + (size_t)t * PC), u);
            int l2 = t - hw, h2 = l2 + w; l2 = l2 < 0 ? 0 : l2; h2 = h2 > n ? n : h2;
            const float inv = __builtin_amdgcn_rcpf((float)(h2 - l2));
#pragma unroll
            for (int e = 0; e < 8; ++e) o[e] = sm[e] * inv - u[e];
            *(f32x4*)(PL + (size_t)(r0 + i) * 512 + ch) = __builtin_bit_cast(f32x4, pack8(o));
            const int ta = t + 1 - hw + w - 1, tr = t - hw;
            if (ta < n) { float x[8]; unpack8(*(const u32x4*)(src + (size_t)ta * PC), x);
#pragma unroll
                for (int e = 0; e < 8; ++e) sm[e] += x[e]; }
            if (tr >= 0) { float x[8]; unpack8(*(const u32x4*)(src + (size_t)tr * PC), x);
#pragma unroll
                for (int e = 0; e < 8; ++e) sm[e] -= x[e]; } }
      }
    }
    for (long it = gthr; it < (long)TT * 24; it += nthr) { const int r = (int)(it / 24), j = (int)(it % 24);
        const float x = bf2f(P[(size_t)r * PC + PDT + j]) + dtb[j]; DT[it] = fmaxf(x, 0.f) + log1pf(__expf(-fabsf(x))); }
}

__device__ __forceinline__ void phase_ssd_naive(Frame& F, int layer) {
    const bf16_t* XA = WSP(bf16_t, WS_XA); const float* DT = WSP(float, WS_SMALL + SM_DT);
    for (int u = F.bid + F.G * F.wave; u < NB * 24; u += F.G * NWAVES) {
        const int b = u / 24, rem = u % 24, head = rem >> 1, dir = rem & 1, g = head / 6;
        const float a = -__expf(F.in[12][layer * 24 + dir * 12 + head]);
        bf16_t* Y = dir ? WSP(bf16_t, WS_YB) : WSP(bf16_t, WS_YF);
        float h[128];
#pragma unroll
        for (int n = 0; n < 128; ++n) h[n] = 0.f;
        for (int step = 0; step < CTXL + SEQ; ++step) {
            int row;
            if (step < CTXL) { const int t = dir ? CTXL - 1 - step : step; row = TL + b * CTXL + t; }
            else { const int s2 = step - CTXL, t = dir ? SEQ - 1 - s2 : s2; row = b * SEQ + t; }
            const float dtv = DT[(size_t)row * 24 + dir * 12 + head], dA = __expf(a * dtv);
            const float dtx = dtv * bf2f(XA[(size_t)row * XAC + head * 64 + F.lane]);
            const u32x4* Bp = (const u32x4*)(XA + (size_t)row * XAC + 768 + g * 128); const u32x4* Cp = (const u32x4*)(XA + (size_t)row * XAC + 1024 + g * 128);
            float y = 0.f;
#pragma unroll
            for (int n8 = 0; n8 < 16; ++n8) { float bv[8], cv[8]; unpack8(Bp[n8], bv); unpack8(Cp[n8], cv);
#pragma unroll
                for (int i = 0; i < 8; ++i) { h[n8 * 8 + i] = h[n8 * 8 + i] * dA + dtx * bv[i]; y += cv[i] * h[n8 * 8 + i]; } }
            Y[(size_t)row * 768 + head * 64 + F.lane] = f2bf(y);
        }
    }
}

namespace ssd {
constexpr int LD = 144;
constexpr int LDX = 80;
constexpr int OFF_C = 0, OFF_B = 36864, OFF_XD = 73728, OFF_XDD = 94208, OFF_H = 114688, OFF_ACS = 147456 + 256;
typedef short v4i16_t __attribute__((ext_vector_type(4)));
__device__ __forceinline__ bf16x8 tr2(const LAS unsigned char* p0, const LAS unsigned char* p1) {
    const v4i16_t a = __builtin_amdgcn_ds_read_tr16_b64_v4i16((LAS v4i16_t*)p0), b = __builtin_amdgcn_ds_read_tr16_b64_v4i16((LAS v4i16_t*)p1);
    return (bf16x8){a[0], a[1], a[2], a[3], b[0], b[1], b[2], b[3]};
}
template <int NP>
__device__ __forceinline__ void chunk_math(const LAS bf16_t* Cs, const LAS bf16_t* Bs, const LAS bf16_t* Hb, const LAS unsigned char* trXd, const LAS unsigned char* trXdd, const LAS unsigned char* trB,
                                           const LAS float* acs, int lb, int fr, int fq, int fo, f32x4 (&sacc)[4], f32x4 (&yout)[4]) {
#define FRAG(base, row0, ks) (*(const LAS bf16x8*)((base) + (row0) * LD + fo + (ks) * 32))
    bf16x8 fc[4];
#pragma unroll
    for (int ks = 0; ks < 4; ++ks) fc[ks] = FRAG(Cs, lb * 16, ks);
    const int l = lb * 16 + fr; const float al = acs[l];
    bf16x8 fbt[4];
#pragma unroll
    for (int ks = 0; ks < 4; ++ks) fbt[ks] = tr2(trB + (ks * 32 * LD) * 2, trB + ((ks * 32 + 4) * LD) * 2);
    f32x4 yo[4];
#pragma unroll
    for (int pt = 0; pt < 4; ++pt) { yo[pt] = (f32x4){0.f, 0.f, 0.f, 0.f}; sacc[pt] = (f32x4){0.f, 0.f, 0.f, 0.f};
        bf16x8 fx[4], fh[4];
#pragma unroll
        for (int ks = 0; ks < 4; ++ks) { fh[ks] = FRAG(Hb, pt * 16, ks); fx[ks] = tr2(trXdd + (ks * 32 * LDX + pt * 16) * 2, trXdd + ((ks * 32 + 4) * LDX + pt * 16) * 2); }
#pragma unroll
        for (int ks = 0; ks < 4; ++ks) { yo[pt] = __builtin_amdgcn_mfma_f32_16x16x32_bf16(fh[ks], fc[ks], yo[pt], 0, 0, 0);
            sacc[pt] = __builtin_amdgcn_mfma_f32_16x16x32_bf16(fbt[ks], fx[ks], sacc[pt], 0, 0, 0); }
        __builtin_amdgcn_sched_barrier(0); }
    const float el = __expf(al);
#pragma unroll
    for (int pt = 0; pt < 4; ++pt) yout[pt] = yo[pt] * el;
#pragma unroll
    for (int j = 0; j < NP; ++j) {
        float gv[8];
#pragma unroll
        for (int h = 0; h < 2; ++h) { const int t = 2 * j + h; bf16x8 fb[4];
#pragma unroll
            for (int ks = 0; ks < 4; ++ks) fb[ks] = FRAG(Bs, t * 16, ks);
            f32x4 cb = (f32x4){0.f, 0.f, 0.f, 0.f};
#pragma unroll
            for (int ks = 0; ks < 4; ++ks) cb = __builtin_amdgcn_mfma_f32_16x16x32_bf16(fb[ks], fc[ks], cb, 0, 0, 0);
            const f32x4 as4 = *(const LAS f32x4*)(acs + t * 16 + 4 * fq);
#pragma unroll
            for (int jj = 0; jj < 4; ++jj) gv[4 * h + jj] = (t * 16 + 4 * fq + jj <= l) ? cb[jj] * __expf(al - as4[jj]) : 0.f; }
        const u32x4 gp = (u32x4){cvt_pk_bf16(gv[0], gv[1]), cvt_pk_bf16(gv[2], gv[3]), cvt_pk_bf16(gv[4], gv[5]), cvt_pk_bf16(gv[6], gv[7])}; const bf16x8 fg = __builtin_bit_cast(bf16x8, gp);
#pragma unroll
        for (int pt = 0; pt < 4; ++pt) { const bf16x8 fx = tr2(trXd + ((2 * j) * 16 * LDX + pt * 16) * 2, trXd + ((2 * j + 1) * 16 * LDX + pt * 16) * 2);
            yout[pt] = __builtin_amdgcn_mfma_f32_16x16x32_bf16(fx, fg, yout[pt], 0, 0, 0); }
        __builtin_amdgcn_sched_barrier(0); }
#undef FRAG
}
}
__device__ __forceinline__ void phase_ssd(Frame& F, int layer) {
    using namespace ssd;
    const bf16_t* XA = WSP(bf16_t, WS_XA); const float* DT = WSP(float, WS_SMALL + SM_DT);
    LAS bf16_t* Cs = (LAS bf16_t*)(F.lds + OFF_C); LAS bf16_t* Bs = (LAS bf16_t*)(F.lds + OFF_B); LAS bf16_t* Xd = (LAS bf16_t*)(F.lds + OFF_XD);
    LAS bf16_t* Xdd = (LAS bf16_t*)(F.lds + OFF_XDD); LAS bf16_t* Hb = (LAS bf16_t*)(F.lds + OFF_H);
    LAS float* acs0 = (LAS float*)(F.lds + OFF_ACS);
    const int tid = F.tid, lane = F.lane, w = F.wave, fr = lane & 15, fq = lane >> 4;
    const int fo = fr * LD + fq * 8;
    const int lb = w < 4 ? w : 11 - w;
    const int tq = fr >> 2, tp = fr & 3;
    const LAS unsigned char* trXd = (const LAS unsigned char*)Xd + ((4 * fq + tq) * LDX + 4 * tp) * 2;
    const LAS unsigned char* trXdd = (const LAS unsigned char*)Xdd + ((8 * fq + tq) * LDX + 4 * tp) * 2;
    const LAS unsigned char* trB = (const LAS unsigned char*)Bs + ((8 * fq + tq) * LD + w * 16 + 4 * tp) * 2;
    for (int uu_ = F.bid; uu_ < NB * 24 * SSD_REP; uu_ += F.G) {
        const int u = uu_ % (NB * 24);
        const int b = u / 24, rem = u % 24, head = rem >> 1, dir = rem & 1, g = head / 6;
        const float a = -__expf(F.in[12][layer * 24 + dir * 12 + head]);
        bf16_t* Y = dir ? WSP(bf16_t, WS_YB) : WSP(bf16_t, WS_YF);
        const int sgn = dir ? -1 : 1;
        f32x4 hreg[4];
#pragma unroll
        for (int pt = 0; pt < 4; ++pt) hreg[pt] = (f32x4){0.f, 0.f, 0.f, 0.f};
        __syncthreads();
        for (int i = tid; i < 64 * LD / 2; i += NTHR) ((LAS unsigned*)Hb)[i] = 0u;
#define RBASE(c) ((c) < 2 ? (dir ? TL + b * CTXL + CTXL - 1 - (c) * 128 : TL + b * CTXL + (c) * 128) : (dir ? b * SEQ + SEQ - 1 - ((c) - 2) * 128 : b * SEQ + ((c) - 2) * 128))
        struct Raw { u32x4 rB[4], rC[4], rX[2]; float dt0, dt1; };
        Raw RA, RBs; RA.dt0 = RA.dt1 = RBs.dt0 = RBs.dt1 = 0.f;
#define SSD_LOAD(S, c) do { const int _rb = RBASE(c); \
        _Pragma("unroll") for (int i = 0; i < 4; ++i) { const int q_ = tid + 512 * i, s_ = q_ >> 4, ch = q_ & 15; const bf16_t* rp = XA + (size_t)(_rb + sgn * s_) * XAC;     \
            S.rB[i] = *(const u32x4*)(rp + 768 + g * 128 + ch * 8); S.rC[i] = *(const u32x4*)(rp + 1024 + g * 128 + ch * 8); } \
        _Pragma("unroll") for (int i = 0; i < 2; ++i) { const int q_ = tid + 512 * i, s_ = q_ >> 3, ch = q_ & 7; S.rX[i] = *(const u32x4*)(XA + (size_t)(_rb + sgn * s_) * XAC + head * 64 + ch * 8); } \
        S.dt0 = DT[(size_t)(_rb + sgn * (2 * lane)) * 24 + dir * 12 + head]; S.dt1 = DT[(size_t)(_rb + sgn * (2 * lane + 1)) * 24 + dir * 12 + head]; } while (0)
        SSD_LOAD(RA, 0);
        SSD_LOAD(RBs, 1);
#define SSD_SCAN(S, buf) do { if (w == 0) { const float sm = S.dt0 + S.dt1; float incl = sm; \
            _Pragma("unroll") for (int o = 1; o < 64; o <<= 1) { const float t = __shfl_up(incl, o); if (lane >= o) incl += t; } \
            const float excl = incl - sm; LAS float* ac_ = acs0 + (buf) * 256; LAS float* dt_ = ac_ + 128; \
            ac_[2 * lane] = a * (excl + S.dt0); ac_[2 * lane + 1] = a * incl; dt_[2 * lane] = S.dt0; dt_[2 * lane + 1] = S.dt1; } } while (0)
        SSD_SCAN(RA, 0);
        __syncthreads();
        auto chunk = [&](const int c, Raw& S, const Raw& T) __attribute__((always_inline)) {
            LAS float* acs = acs0 + (c & 1) * 256; LAS float* dts = acs + 128;
            const float acs_last = acs[127];
#pragma unroll
            for (int i = 0; i < 4; ++i) { const int q_ = tid + 512 * i, s_ = q_ >> 4, ch = q_ & 15;
                *(LAS u32x4*)(Cs + s_ * LD + ch * 8) = S.rC[i]; *(LAS u32x4*)(Bs + s_ * LD + ch * 8) = S.rB[i]; }
#pragma unroll
            for (int i = 0; i < 2; ++i) { const int q_ = tid + 512 * i, s_ = q_ >> 3, ch = q_ & 7; const float dv = dts[s_], es = __expf(acs_last - acs[s_]); float xv[8]; unpack8(S.rX[i], xv);
#pragma unroll
                for (int e = 0; e < 8; ++e) xv[e] *= dv;
                *(LAS u32x4*)(Xd + s_ * LDX + ch * 8) = pack8(xv);
#pragma unroll
                for (int e = 0; e < 8; ++e) xv[e] *= es;
                *(LAS u32x4*)(Xdd + s_ * LDX + ch * 8) = pack8(xv); }
            SSD_LOAD(S, (c + 2 < 18 ? c + 2 : 17));
            __syncthreads();
            f32x4 sacc[4], yv[4];
            switch (lb >> 1) {
                case 0: chunk_math<1>(Cs, Bs, Hb, trXd, trXdd, trB, acs, lb, fr, fq, fo, sacc, yv); break;
                case 1: chunk_math<2>(Cs, Bs, Hb, trXd, trXdd, trB, acs, lb, fr, fq, fo, sacc, yv); break;
                case 2: chunk_math<3>(Cs, Bs, Hb, trXd, trXdd, trB, acs, lb, fr, fq, fo, sacc, yv); break;
                default: chunk_math<4>(Cs, Bs, Hb, trXd, trXdd, trB, acs, lb, fr, fq, fo, sacc, yv); break;
            }
            { bf16_t* ydst = Y + (size_t)(RBASE(c) + sgn * (lb * 16 + fr)) * 768 + head * 64 + 4 * fq;
#pragma unroll
              for (int pt = 0; pt < 4; ++pt) { u32x2 o; o.x = cvt_pk_bf16(yv[pt][0], yv[pt][1]); o.y = cvt_pk_bf16(yv[pt][2], yv[pt][3]); *(u32x2*)(ydst + pt * 16) = o; } }
            if (c + 1 < 18) SSD_SCAN(T, (c + 1) & 1);
            __syncthreads();
            { const float ea = __expf(acs_last);
#pragma unroll
              for (int pt = 0; pt < 4; ++pt) { hreg[pt] = hreg[pt] * ea + sacc[pt];
                  u32x2 o; o.x = cvt_pk_bf16(hreg[pt][0], hreg[pt][1]); o.y = cvt_pk_bf16(hreg[pt][2], hreg[pt][3]); *(LAS u32x2*)(Hb + (pt * 16 + fr) * LD + w * 16 + 4 * fq) = o; } }
        };
        for (int c = 0; c < 18; c += 2) { chunk(c, RA, RBs); chunk(c + 1, RBs, RA); }
#undef RBASE
#undef SSD_LOAD
#undef SSD_SCAN
#undef FRAG
    }
    __syncthreads();
}

__device__ __forceinline__ void phase_qkv_final(Frame& F, int layer) {
    const int gw = F.bid * NWAVES + F.wave, NGW = F.G * NWAVES, lane = F.lane;
    const bf16_t* P = WSP(bf16_t, WS_P); bf16_t* QR = WSP(bf16_t, WS_QR); bf16_t* KV = WSP(bf16_t, WS_KVR);
    const float* tab = WSP(float, WS_SMALL + SM_ROPE);
    const int hs = lane >> 5, ck = lane & 31; const bool act = ck < 24, rp = ck >= 16 && act;
    float qw[8], kw[8];
    { const float* a = F.in[21] + layer * 192 + (act ? ck : 0) * 8; const float* b = F.in[22] + layer * 192 + (act ? ck : 0) * 8;
#pragma unroll
      for (int e = 0; e < 8; ++e) { qw[e] = a[e]; kw[e] = b[e]; } }
    const int ra = (ck - 16) >> 2, rj0 = ((ck - 16) & 1) * 8; const bool rhi = ((ck - 16) >> 1) & 1;
#if FP8_PV
    LAS unsigned char* Vs = F.lds;
    __syncthreads();
    const int nlat = TL / 64, nctx = TC / 64, Lr = (nlat + F.G - 1) / F.G, Cr = (nctx + F.G - 1) / F.G;
    for (int rd = 0; rd < Lr + Cr; ++rd) {
        int tl;
        if (rd < Lr) { tl = F.bid + rd * F.G; if (tl >= nlat) continue; }
        else { const int jc = (F.G - 1 - F.bid) + (rd - Lr) * F.G; if (jc >= nctx) continue; tl = nlat + jc; }
    for (int rr_ = 0; rr_ < 8; ++rr_) { const int r = tl * 64 + F.wave * 8 + rr_;
#else
    for (int r = gw; r < TT; r += NGW) {
#endif
        const bool lat = r < TL; const int t = lat ? (r & 2047) : 0;
        float x[8]; float ss = 0.f;
        unpack8(*(const u32x4*)(P + (size_t)r * PC + PCQ + lane * 8), x);
#pragma unroll
        for (int e = 0; e < 8; ++e) ss += x[e] * x[e];
        const float rq = rsqrtf(wave_sum(ss) * (1.0f / 512.0f) + EPS);
        unpack8(*(const u32x4*)(P + (size_t)r * PC + PCKV + lane * 8), x); ss = 0.f;
#pragma unroll
        for (int e = 0; e < 8; ++e) ss += x[e] * x[e];
        const float rkv = rsqrtf(wave_sum(ss) * (1.0f / 512.0f) + EPS);
        float cs[8], sn[8];
        if (rp && lat) { const int pos = ra ? (t & 63) : (t >> 6); const f32x4* tp = (const f32x4*)(tab + (pos * 16 + rj0) * 2);
#pragma unroll
            for (int q = 0; q < 4; ++q) { const f32x4 v = tp[q]; cs[2 * q] = v[0]; sn[2 * q] = v[1]; cs[2 * q + 1] = v[2]; sn[2 * q + 1] = v[3]; } }
        else {
#pragma unroll
            for (int e = 0; e < 8; ++e) { cs[e] = 1.f; sn[e] = 0.f; } }
        if (lat || layer == 0) {
            bf16_t* q = QR + (size_t)r * QC;
            u32x4 rawq[3];
#pragma unroll
            for (int ps = 0; ps < 3; ++ps) rawq[ps] = act ? *(const u32x4*)(q + (ps * 2 + hs) * 192 + ck * 8) : (u32x4){0u, 0u, 0u, 0u};
#pragma unroll
            for (int ps = 0; ps < 3; ++ps) { bf16_t* qp = q + (ps * 2 + hs) * 192 + ck * 8; float a[8]; float s2 = 0.f;
                if (act) unpack8(rawq[ps], a); else {
#pragma unroll
                    for (int e = 0; e < 8; ++e) a[e] = 0.f; }
#pragma unroll
                for (int e = 0; e < 8; ++e) { a[e] *= rq; s2 += a[e] * a[e]; }
#pragma unroll
                for (int o = 1; o < 32; o <<= 1) s2 += __shfl_xor(s2, o);
                const float rs = rsqrtf(s2 * (1.0f / 192.0f) + EPS) * ATT_QKFOLD;
#pragma unroll
                for (int e = 0; e < 8; ++e) { a[e] *= rs * qw[e]; const float pr = __shfl_xor(a[e], 2); a[e] = rhi ? a[e] * cs[e] + pr * sn[e] : a[e] * cs[e] - pr * sn[e]; }
#if FP8_QK
                if (act) { u32x2 w8; w8.x = pack4_fp8(a[0], a[1], a[2], a[3]); w8.y = pack4_fp8(a[4], a[5], a[6], a[7]); *(u32x2*)((unsigned char*)q + (ps * 2 + hs) * 192 + ck * 8) = w8; }
#else
                if (act) *(u32x4*)qp = pack8(a);
#endif
            }
        }
        bf16_t* kv = KV + (size_t)r * KVC;
        u32x4 rawk[3];
#pragma unroll
        for (int ps = 0; ps < 3; ++ps) rawk[ps] = act ? (rp ? *(const u32x4*)(P + (size_t)r * PC + PKR + (ck - 16) * 8) : *(const u32x4*)(kv + (ps * 2 + hs) * 320 + ck * 8)) : (u32x4){0u, 0u, 0u, 0u};
#pragma unroll
        for (int ps = 0; ps < 3; ++ps) { bf16_t* kp = kv + (ps * 2 + hs) * 320 + ck * 8; float a[8]; float s2 = 0.f;
            if (act) unpack8(rawk[ps], a); else {
#pragma unroll
                for (int e = 0; e < 8; ++e) a[e] = 0.f; }
            const float sc = rp ? 1.f : rkv;
#pragma unroll
            for (int e = 0; e < 8; ++e) { a[e] *= sc; s2 += a[e] * a[e]; }
#pragma unroll
            for (int o = 1; o < 32; o <<= 1) s2 += __shfl_xor(s2, o);
            const float rs = rsqrtf(s2 * (1.0f / 192.0f) + EPS) * ATT_QKFOLD;
#pragma unroll
            for (int e = 0; e < 8; ++e) { a[e] *= rs * kw[e]; const float pr = __shfl_xor(a[e], 2); a[e] = rhi ? a[e] * cs[e] + pr * sn[e] : a[e] * cs[e] - pr * sn[e]; }
#if FP8_QK
            if (act) { u32x2 w8; w8.x = pack4_fp8(a[0], a[1], a[2], a[3]); w8.y = pack4_fp8(a[4], a[5], a[6], a[7]); *(u32x2*)((unsigned char*)(kv + (ps * 2 + hs) * 320) + ck * 8) = w8; }
#else
            if (act) *(u32x4*)kp = pack8(a);
#endif
        }
#if FP8_PV
#pragma unroll
        for (int ps = 0; ps < 2; ++ps) { const int c = lane + 64 * ps;
            if (c < 96) { const bf16_t* vp = kv + (c >> 4) * 320 + 192 + (c & 15) * 8; float a[8]; unpack8(*(const u32x4*)vp, a);
                u32x2 w8; w8.x = pack4_fp8(a[0] * rkv, a[1] * rkv, a[2] * rkv, a[3] * rkv); w8.y = pack4_fp8(a[4] * rkv, a[5] * rkv, a[6] * rkv, a[7] * rkv);
                *(LAS u32x2*)(Vs + (r & 63) * 768 + c * 8) = w8; } }
#else
#pragma unroll
        for (int ps = 0; ps < 2; ++ps) { const int c = lane + 64 * ps;
            if (c < 96) { bf16_t* vp = kv + (c >> 4) * 320 + 192 + (c & 15) * 8; float a[8]; unpack8(*(const u32x4*)vp, a);
#pragma unroll
                for (int e = 0; e < 8; ++e) a[e] *= rkv;
                *(u32x4*)vp = pack8(a); } }
#endif
    }
#if FP8_PV
        __syncthreads();
        { const bool latt = tl < TL / 64; const int bb = latt ? (tl >> 5) : ((tl - TL / 64) >> 2), tile = latt ? 4 + (tl & 31) : ((tl - TL / 64) & 3);
#pragma unroll
          for (int it = 0; it < 6; ++it) { const int hh = it, t = F.tid, col = t >> 2, sci = t & 3, ci = sci ^ ((col >> 2) & 3);
              unsigned wq[4];
#pragma unroll
              for (int q = 0; q < 4; ++q) { unsigned wv = 0;
#pragma unroll
                  for (int i2 = 0; i2 < 4; ++i2) { const int kb = ci * 16 + q * 4 + i2, khi = kb >> 5, e = kb & 31, e16 = e & 15, kk = (e16 & 3) + 8 * (e16 >> 2) + 4 * khi + (e >> 4) * 32;
                      wv |= (unsigned)Vs[kk * 768 + hh * 128 + col] << (8 * i2); }
                  wq[q] = wv; }
              *(u32x4*)(F.ws + WS_VT8 + ((size_t)((bb * 6 + hh) * 36 + tile)) * 8192 + col * 64 + sci * 16) = (u32x4){wq[0], wq[1], wq[2], wq[3]}; } }
        __syncthreads();
    }
#endif
}

template <bool OUT8>
__device__ __forceinline__ void phase_ssd_gate(Frame& F, int layer, int nrows) {
    const int gw = F.bid * NWAVES + F.wave, NGW = F.G * NWAVES, lane = F.lane;
    const bf16_t* P = WSP(bf16_t, WS_P); const bf16_t* XA = WSP(bf16_t, WS_XA); const bf16_t* YF = WSP(bf16_t, WS_YF); const bf16_t* YB = WSP(bf16_t, WS_YB); bf16_t* CAT = WSP(bf16_t, WS_CAT);
    const float* dsk = F.in[13] + layer * 12; const float* nw = F.in[14] + layer * 768;
    for (int r = gw; r < nrows; r += NGW) {
        float gl[12]; float ss = 0.f;
#pragma unroll
        for (int j = 0; j < 3; ++j) { const int c = 256 * j + 4 * lane; const float d = dsk[c >> 6];
            const u32x2 yf = *(const u32x2*)(YF + (size_t)r * 768 + c), yb = *(const u32x2*)(YB + (size_t)r * 768 + c), xs = *(const u32x2*)(XA + (size_t)r * XAC + c), z = *(const u32x2*)(P + (size_t)r * PC + PZ + c);
            const float y0 = bf_lo(yf.x) + bf_lo(yb.x) + bf_lo(xs.x) * d, y1 = bf_hi(yf.x) + bf_hi(yb.x) + bf_hi(xs.x) * d, y2 = bf_lo(yf.y) + bf_lo(yb.y) + bf_lo(xs.y) * d, y3 = bf_hi(yf.y) + bf_hi(yb.y) + bf_hi(xs.y) * d;
            gl[j * 4 + 0] = y0 * silu_f(bf_lo(z.x)); gl[j * 4 + 1] = y1 * silu_f(bf_hi(z.x)); gl[j * 4 + 2] = y2 * silu_f(bf_lo(z.y)); gl[j * 4 + 3] = y3 * silu_f(bf_hi(z.y));
            ss += (gl[j * 4] * gl[j * 4] + gl[j * 4 + 1] * gl[j * 4 + 1]) + (gl[j * 4 + 2] * gl[j * 4 + 2] + gl[j * 4 + 3] * gl[j * 4 + 3]); }
        const float rs = rsqrtf(wave_sum(ss) * (1.0f / 768.0f) + EPS);
#pragma unroll
        for (int j = 0; j < 3; ++j) { const int c = 256 * j + 4 * lane; const f32x4 w4 = *(const f32x4*)(nw + c);
            if constexpr (OUT8) *(float*)((unsigned char*)CAT + (size_t)r * DM + c) = __uint_as_float(pack4_fp8(gl[j * 4] * rs * w4[0], gl[j * 4 + 1] * rs * w4[1], gl[j * 4 + 2] * rs * w4[2], gl[j * 4 + 3] * rs * w4[3]));
            else { u32x2 o; o.x = cvt_pk_bf16(gl[j * 4] * rs * w4[0], gl[j * 4 + 1] * rs * w4[1]); o.y = cvt_pk_bf16(gl[j * 4 + 2] * rs * w4[2], gl[j * 4 + 3] * rs * w4[3]);
                *(f32x2*)(CAT + (size_t)r * DM + c) = __builtin_bit_cast(f32x2, o); } }
    }
}

namespace attn {
typedef int i32x4a __attribute__((ext_vector_type(4)));
typedef int i32x8a __attribute__((ext_vector_type(8)));
typedef short s16x4 __attribute__((ext_vector_type(4)));
typedef float f32x16 __attribute__((ext_vector_type(16)));
constexpr int KVBLK = 64;
constexpr float SCALE = 0.07216878364870322f;
#if FP8_PV
constexpr float THR = 3.f, PSHIFT = 4.f;
#else
constexpr float THR = 8.f, PSHIFT = 0.f;
#endif
constexpr int SHM_V = 64 * 128 * 2, SHM_K = 64 * 192 * 2;
constexpr int ATTN_LDS = 2 * SHM_V + 2 * SHM_K + 8 * 64 * 4;
__device__ __forceinline__ void pv8(f32x16 (&o)[4], const LAS unsigned char* Vt, const f32x16& p0, const f32x16& p1, int r32, int hi) {
    i32x8a pa;
#pragma unroll
    for (int g = 0; g < 4; ++g) { int w0 = 0, w1 = 0;
        w0 = __builtin_amdgcn_cvt_pk_fp8_f32(p0[4 * g], p0[4 * g + 1], w0, false); w0 = __builtin_amdgcn_cvt_pk_fp8_f32(p0[4 * g + 2], p0[4 * g + 3], w0, true);
        w1 = __builtin_amdgcn_cvt_pk_fp8_f32(p1[4 * g], p1[4 * g + 1], w1, false); w1 = __builtin_amdgcn_cvt_pk_fp8_f32(p1[4 * g + 2], p1[4 * g + 3], w1, true);
        pa[g] = w0; pa[4 + g] = w1; }
    i32x8a vb[4];
#pragma unroll
    for (int d0 = 0; d0 < 4; ++d0) { const int col = d0 * 32 + r32, f = (col >> 2) & 3; const LAS unsigned char* rowp = Vt + col * 64;
        const i32x4a lo = *(const LAS i32x4a*)(rowp + (((2 * hi) ^ f) << 4)), hi4 = *(const LAS i32x4a*)(rowp + (((2 * hi + 1) ^ f) << 4));
        vb[d0] = __builtin_shufflevector(lo, hi4, 0, 1, 2, 3, 4, 5, 6, 7); }
    asm volatile("s_nop 3" : "+v"(pa));
#pragma unroll
    for (int d0 = 0; d0 < 4; ++d0) asm volatile("v_mfma_f32_32x32x64_f8f6f4 %0, %1, %2, %0" : "+v"(o[d0]) : "v"(pa), "v"(vb[d0]));
}
#define KSWZ8(row, colB) ((row) * 192 + ((colB) ^ ((((row) >> 2) & 3) << 4)))
constexpr int SHM_K8 = 64 * 192;
__device__ __forceinline__ void qkt8(f32x16& p0, f32x16& p1, const LAS unsigned char* Ks, const i32x4a (&q8)[6], int r32, int hi, float bias = 0.f) {
#pragma unroll
    for (int r = 0; r < 16; ++r) { p0[r] = bias; p1[r] = bias; }
    i32x8a ka[3], kb[3];
#pragma unroll
    for (int t = 0; t < 3; ++t) { const int cb = t * 64 + hi * 32;
        const i32x4a a0 = *(const LAS i32x4a*)(Ks + KSWZ8(r32, cb)), a1 = *(const LAS i32x4a*)(Ks + KSWZ8(r32, cb + 16));
        const i32x4a b0 = *(const LAS i32x4a*)(Ks + KSWZ8(32 + r32, cb)), b1 = *(const LAS i32x4a*)(Ks + KSWZ8(32 + r32, cb + 16));
        ka[t] = __builtin_shufflevector(a0, a1, 0, 1, 2, 3, 4, 5, 6, 7); kb[t] = __builtin_shufflevector(b0, b1, 0, 1, 2, 3, 4, 5, 6, 7); }
    asm volatile("s_nop 1" ::: "memory");
#pragma unroll
    for (int t = 0; t < 3; ++t) { const i32x8a qq = __builtin_shufflevector(q8[2 * t], q8[2 * t + 1], 0, 1, 2, 3, 4, 5, 6, 7);
        asm volatile("v_mfma_f32_32x32x64_f8f6f4 %0, %1, %2, %0" : "+v"(p0) : "v"(ka[t]), "v"(qq));
        asm volatile("v_mfma_f32_32x32x64_f8f6f4 %0, %1, %2, %0" : "+v"(p1) : "v"(kb[t]), "v"(qq)); }
    asm volatile("s_nop 15\n\ts_nop 7" : "+v"(p0), "+v"(p1));
}
#define KSWZ(row, colB) ((row) * 384 + ((colB) ^ ((((row) >> 1) & 7) << 4)))
#define SBAR() __builtin_amdgcn_sched_barrier(0)
__device__ __forceinline__ int crow(int r, int hi) { return (r & 3) + 8 * (r >> 2) + 4 * hi; }
__device__ __forceinline__ void partialSM(f32x16& p0, f32x16& p1, float& m_reg, float& mn, float& alpha) {
    constexpr float C = SCALE * 1.4426950408889634f;
    float pmax = p0[0];
#pragma unroll
    for (int r = 1; r < 16; ++r) pmax = fmaxf(pmax, p0[r]);
#pragma unroll
    for (int r = 0; r < 16; ++r) pmax = fmaxf(pmax, p1[r]);
    { auto rr = __builtin_amdgcn_permlane32_swap(__float_as_uint(pmax), __float_as_uint(pmax), false, false); pmax = fmaxf(__uint_as_float(rr[0]), __uint_as_float(rr[1])); }
    if (__builtin_expect(__all(pmax - m_reg <= THR / SCALE), 1)) { mn = m_reg; alpha = 1.f; }
    else { mn = fmaxf(m_reg, pmax); alpha = __builtin_amdgcn_exp2f((m_reg - mn) * C); m_reg = mn; }
    const float mnC = -mn * C + PSHIFT;
#pragma unroll
    for (int r = 0; r < 16; ++r) p0[r] = fmaf(p0[r], C, mnC);
#pragma unroll
    for (int r = 0; r < 16; ++r) p1[r] = fmaf(p1[r], C, mnC);
#pragma unroll
    for (int r = 0; r < 16; ++r) p0[r] = __builtin_amdgcn_exp2f(p0[r]);
}
__device__ __forceinline__ void finishSM(f32x16& p0, f32x16& p1, float alpha, float& l_reg, bf16x8& pa0, bf16x8& pa1, bf16x8& pa2, bf16x8& pa3) {
#pragma unroll
    for (int r = 0; r < 16; ++r) p1[r] = __builtin_amdgcn_exp2f(p1[r]);
    float ps = 0;
#pragma unroll
    for (int r = 0; r < 16; ++r) ps += p0[r];
#pragma unroll
    for (int r = 0; r < 16; ++r) ps += p1[r];
    { auto rr = __builtin_amdgcn_permlane32_swap(__float_as_uint(ps), __float_as_uint(ps), false, false); ps = __uint_as_float(rr[0]) + __uint_as_float(rr[1]); }
    l_reg = l_reg * alpha + ps;
#define PK4(P, BASE, OUT) do { unsigned a0 = cvt_pk_bf16(P[BASE + 0], P[BASE + 1]), a1 = cvt_pk_bf16(P[BASE + 2], P[BASE + 3]);   \
    unsigned b0 = cvt_pk_bf16(P[BASE + 4], P[BASE + 5]), b1 = cvt_pk_bf16(P[BASE + 6], P[BASE + 7]);                              \
    auto r0 = __builtin_amdgcn_permlane32_swap(a0, b0, false, false); auto r1 = __builtin_amdgcn_permlane32_swap(a1, b1, false, false); \
    u32x4 w = {r0[0], r1[0], r0[1], r1[1]}; OUT = __builtin_bit_cast(bf16x8, w); } while (0)
    PK4(p0, 0, pa0); PK4(p0, 8, pa1); PK4(p1, 0, pa2); PK4(p1, 8, pa3);
#undef PK4
}
__device__ __forceinline__ void partialSM8(f32x16& p0, f32x16& p1, float& m_reg, float& alpha, bool first) {
    constexpr float THRL = THR * 1.4426950408889634f;
    float pmax = p0[0];
#pragma unroll
    for (int r = 1; r < 16; ++r) pmax = fmaxf(pmax, p0[r]);
#pragma unroll
    for (int r = 0; r < 16; ++r) pmax = fmaxf(pmax, p1[r]);
    { auto rr = __builtin_amdgcn_permlane32_swap(__float_as_uint(pmax), __float_as_uint(pmax), false, false); pmax = fmaxf(__uint_as_float(rr[0]), __uint_as_float(rr[1])); }
    const float excess = pmax - PSHIFT;
    if (__builtin_expect(!first && __all(excess <= THRL), 1)) alpha = 1.f;
    else { const float delta = first ? excess : fmaxf(excess, 0.f); alpha = first ? 1.f : __builtin_amdgcn_exp2f(-delta); m_reg += delta;
#pragma unroll
        for (int r = 0; r < 16; ++r) { p0[r] -= delta; p1[r] -= delta; } }
#pragma unroll
    for (int r = 0; r < 16; ++r) p0[r] = __builtin_amdgcn_exp2f(p0[r]);
}
__device__ __forceinline__ void finishSM8(f32x16& p0, f32x16& p1, float alpha, float& l_reg) {
#pragma unroll
    for (int r = 0; r < 16; ++r) p1[r] = __builtin_amdgcn_exp2f(p1[r]);
    float ps = 0;
#pragma unroll
    for (int r = 0; r < 16; ++r) ps += p0[r];
#pragma unroll
    for (int r = 0; r < 16; ++r) ps += p1[r];
    { auto rr = __builtin_amdgcn_permlane32_swap(__float_as_uint(ps), __float_as_uint(ps), false, false); ps = __uint_as_float(rr[0]) + __uint_as_float(rr[1]); }
    l_reg = l_reg * alpha + ps;
}
__device__ __forceinline__ void qkt(f32x16& p0, f32x16& p1, const LAS unsigned char* Ks, const bf16x8 (&qr)[12], int r32, int hi) {
#pragma unroll
    for (int r = 0; r < 16; ++r) { p0[r] = 0.f; p1[r] = 0.f; }
#pragma unroll
    for (int d0 = 0; d0 < 12; ++d0) { const int cb = (d0 * 16 + hi * 8) * 2;
        const bf16x8 b0 = *(const LAS bf16x8*)(Ks + KSWZ(r32, cb));
        const bf16x8 b1 = *(const LAS bf16x8*)(Ks + KSWZ(32 + r32, cb));
        p0 = __builtin_amdgcn_mfma_f32_32x32x16_bf16(b0, qr[d0], p0, 0, 0, 0);
        p1 = __builtin_amdgcn_mfma_f32_32x32x16_bf16(b1, qr[d0], p1, 0, 0, 0); }
}
__device__ __forceinline__ int v_st(int k, int c) { const int kk = (k & ~0xC) | ((k & 4) << 1) | ((k & 8) >> 1); return ((kk >> 3) * 4 + (c >> 5)) * 512 + ((kk & 7) * 32 + (c & 31)) * 2; }
__device__ __forceinline__ int v_rd_base(int lane) { return ((lane & 3) << 3) | (((lane >> 2) & 3) << 6) | (((lane >> 4) & 1) << 5) | (((lane >> 5) & 1) << 8); }
constexpr int v_rd_off(int d0, int ks, int half) { return d0 * 512 + ks * 4096 + half * 2048; }
template <int OFF> __device__ __forceinline__ s16x4 tr_read(int vb) { s16x4 r; asm volatile("ds_read_b64_tr_b16 %0, %1 offset:%2" : "=&v"(r) : "v"(vb), "i"(OFF) : "memory"); return r; }
template <int D0> __device__ __forceinline__ void pv_one(f32x16& od, int vb, bf16x8 pa0, bf16x8 pa1, bf16x8 pa2, bf16x8 pa3) {
    const s16x4 l0 = tr_read<v_rd_off(D0, 0, 0)>(vb), h0 = tr_read<v_rd_off(D0, 0, 1)>(vb), l1 = tr_read<v_rd_off(D0, 1, 0)>(vb), h1 = tr_read<v_rd_off(D0, 1, 1)>(vb);
    const s16x4 l2 = tr_read<v_rd_off(D0, 2, 0)>(vb), h2 = tr_read<v_rd_off(D0, 2, 1)>(vb), l3 = tr_read<v_rd_off(D0, 3, 0)>(vb), h3 = tr_read<v_rd_off(D0, 3, 1)>(vb);
    asm volatile("s_waitcnt lgkmcnt(0)" ::: "memory"); SBAR();
#define PKV(L, H) (bf16x8){L[0], L[1], L[2], L[3], H[0], H[1], H[2], H[3]}
    od = __builtin_amdgcn_mfma_f32_32x32x16_bf16(pa0, PKV(l0, h0), od, 0, 0, 0);
    od = __builtin_amdgcn_mfma_f32_32x32x16_bf16(pa1, PKV(l1, h1), od, 0, 0, 0);
    od = __builtin_amdgcn_mfma_f32_32x32x16_bf16(pa2, PKV(l2, h2), od, 0, 0, 0);
    od = __builtin_amdgcn_mfma_f32_32x32x16_bf16(pa3, PKV(l3, h3), od, 0, 0, 0);
#undef PKV
}
template <int D0> __device__ __forceinline__ void pv_rd(int vb, s16x4 (&l)[4], s16x4 (&h)[4]) {
    l[0] = tr_read<v_rd_off(D0, 0, 0)>(vb); h[0] = tr_read<v_rd_off(D0, 0, 1)>(vb); l[1] = tr_read<v_rd_off(D0, 1, 0)>(vb); h[1] = tr_read<v_rd_off(D0, 1, 1)>(vb);
    l[2] = tr_read<v_rd_off(D0, 2, 0)>(vb); h[2] = tr_read<v_rd_off(D0, 2, 1)>(vb); l[3] = tr_read<v_rd_off(D0, 3, 0)>(vb); h[3] = tr_read<v_rd_off(D0, 3, 1)>(vb);
}
__device__ __forceinline__ void pv_mm(f32x16& od, const s16x4 (&l)[4], const s16x4 (&h)[4], bf16x8 pa0, bf16x8 pa1, bf16x8 pa2, bf16x8 pa3) {
#define PKV(L, H) (bf16x8){L[0], L[1], L[2], L[3], H[0], H[1], H[2], H[3]}
    od = __builtin_amdgcn_mfma_f32_32x32x16_bf16(pa0, PKV(l[0], h[0]), od, 0, 0, 0);
    od = __builtin_amdgcn_mfma_f32_32x32x16_bf16(pa1, PKV(l[1], h[1]), od, 0, 0, 0);
    od = __builtin_amdgcn_mfma_f32_32x32x16_bf16(pa2, PKV(l[2], h[2]), od, 0, 0, 0);
    od = __builtin_amdgcn_mfma_f32_32x32x16_bf16(pa3, PKV(l[3], h[3]), od, 0, 0, 0);
#undef PKV
}
__device__ __forceinline__ void pv_d0(f32x16 (&o)[4], int vb, bf16x8 pa0, bf16x8 pa1, bf16x8 pa2, bf16x8 pa3) {
    s16x4 l0[4], h0[4], l1[4], h1[4];
    pv_rd<0>(vb, l0, h0); pv_rd<1>(vb, l1, h1);
    asm volatile("s_waitcnt lgkmcnt(0)" ::: "memory"); SBAR();
    pv_mm(o[0], l0, h0, pa0, pa1, pa2, pa3); pv_mm(o[1], l1, h1, pa0, pa1, pa2, pa3); SBAR();
    pv_rd<2>(vb, l0, h0); pv_rd<3>(vb, l1, h1);
    asm volatile("s_waitcnt lgkmcnt(0)" ::: "memory"); SBAR();
    pv_mm(o[2], l0, h0, pa0, pa1, pa2, pa3); pv_mm(o[3], l1, h1, pa0, pa1, pa2, pa3);
}
template <bool OUT8>
__device__ __forceinline__ void attn_unit(const bf16_t* __restrict__ QR, const bf16_t* __restrict__ KV, const unsigned char* __restrict__ VT, bf16_t* __restrict__ CAT, int qrow0, int b, int h, int NT, LAS unsigned char* lds) {
    const int tid = threadIdx.x, wid = tid >> 6, lane = tid & 63, r32 = lane & 31, hi = lane >> 5;
    LAS unsigned char* V_lds = lds; LAS unsigned char* K_lds = lds + 2 * SHM_V;
    LAS float* ws = (LAS float*)(lds + 2 * SHM_V + 2 * SHM_K) + wid * 64; LAS float* li_l = ws; LAS float* al_l = ws + 32;
    float m_reg = (FP8_QK && FP8_PV) ? 0.f : -1e30f, l_reg = 0; f32x16 o[4];
#if FP8_QK
    i32x4a q8[6];
#else
    bf16x8 qr[12];
#endif
#pragma unroll
    for (int d = 0; d < 4; ++d)
#pragma unroll
        for (int r = 0; r < 16; ++r) o[d][r] = 0.f;
#if FP8_PV
    const unsigned char* Vt8 = VT + (size_t)((b * 6 + h) * 36) * 8192 + tid * 16;
#endif
    const int sr = tid >> 4, sc = (tid & 15) * 8, vst0 = v_st(sr, sc), vst1 = v_st(32 + sr, sc);
    const int vb0 = (int)(unsigned)(size_t)V_lds + v_rd_base(lane);
    const bf16_t* Vh = KV + h * 320 + 192;
#if FP8_QK
    { const unsigned char* Q8 = (const unsigned char*)(QR + (size_t)(qrow0 + wid * 32 + r32) * QC) + h * 192 + hi * 32;
#pragma unroll
      for (int t = 0; t < 3; ++t) { q8[2 * t] = *(const i32x4a*)(Q8 + t * 64); q8[2 * t + 1] = *(const i32x4a*)(Q8 + t * 64 + 16); } }
    const int kc0 = tid, kc1 = tid + 512;
    const int kr0 = kc0 / 12, kq0 = kc0 % 12, kr1 = kc1 / 12, kq1 = kc1 % 12; const bool k1ok = kc1 < 768;
    const int kst0 = KSWZ8(kr0, kq0 * 16), kst1 = KSWZ8(kr1 & 63, kq1 * 16);
    const unsigned char* Kh8 = (const unsigned char*)(KV + h * 320);
    bf16x8 vs0, vs1; i32x4a ks0, ks1, vs8;
#else
    const bf16_t* Qw = QR + (size_t)(qrow0 + wid * 32 + r32) * QC + h * 192 + hi * 8;
#pragma unroll
    for (int d0 = 0; d0 < 12; ++d0) qr[d0] = *(const bf16x8*)(Qw + d0 * 16);
    const int kc0 = tid, kc1 = tid + 512, kc2 = tid + 1024;
    const int kr0 = kc0 / 24, kq0 = kc0 % 24, kr1 = kc1 / 24, kq1 = kc1 % 24, kr2 = kc2 / 24, kq2 = kc2 % 24;
    const int kst0 = KSWZ(kr0, kq0 * 16), kst1 = KSWZ(kr1, kq1 * 16), kst2 = KSWZ(kr2, kq2 * 16);
    const bf16_t* Kh = KV + h * 320;
    bf16x8 vs0, vs1, ks0, ks1, ks2;
#endif
#define TROW(j) ((j) < 4 ? TL + b * CTXL + (j) * 64 : b * SEQ + ((j) - 4) * 64)
#if FP8_QK && FP8_PV
#define SLOAD(j) do { const size_t _r0 = (size_t)TROW(j); vs8 = *(const i32x4a*)(Vt8 + (size_t)(j) * 8192); \
    ks0 = *(const i32x4a*)(Kh8 + (_r0 + kr0) * (KVC * 2) + kq0 * 16); if (k1ok) ks1 = *(const i32x4a*)(Kh8 + (_r0 + kr1) * (KVC * 2) + kq1 * 16); } while (0)
#define SWRITE(bb) do { *(LAS i32x4a*)(V_lds + (bb) * 8192 + tid * 16) = vs8; \
    *(LAS i32x4a*)(K_lds + (bb) * SHM_K8 + kst0) = ks0; if (k1ok) *(LAS i32x4a*)(K_lds + (bb) * SHM_K8 + kst1) = ks1; } while (0)
#define QKT(pp0, pp1, bb) qkt8(pp0, pp1, K_lds + (bb) * SHM_K8, q8, r32, hi)
#elif FP8_QK
#define SLOAD(j) do { const size_t _r0 = (size_t)TROW(j); vs0 = *(const bf16x8*)(Vh + (_r0 + sr) * KVC + sc); vs1 = *(const bf16x8*)(Vh + (_r0 + 32 + sr) * KVC + sc); \
    ks0 = *(const i32x4a*)(Kh8 + (_r0 + kr0) * (KVC * 2) + kq0 * 16); if (k1ok) ks1 = *(const i32x4a*)(Kh8 + (_r0 + kr1) * (KVC * 2) + kq1 * 16); } while (0)
#define SWRITE(bb) do { *(LAS bf16x8*)(V_lds + (bb) * SHM_V + vst0) = vs0; *(LAS bf16x8*)(V_lds + (bb) * SHM_V + vst1) = vs1; \
    *(LAS i32x4a*)(K_lds + (bb) * SHM_K8 + kst0) = ks0; if (k1ok) *(LAS i32x4a*)(K_lds + (bb) * SHM_K8 + kst1) = ks1; } while (0)
#define QKT(pp0, pp1, bb) qkt8(pp0, pp1, K_lds + (bb) * SHM_K8, q8, r32, hi)
#else
#define SLOAD(j) do { const size_t _r0 = (size_t)TROW(j); vs0 = *(const bf16x8*)(Vh + (_r0 + sr) * KVC + sc); vs1 = *(const bf16x8*)(Vh + (_r0 + 32 + sr) * KVC + sc); \
    ks0 = *(const bf16x8*)(Kh + (_r0 + kr0) * KVC + kq0 * 8); ks1 = *(const bf16x8*)(Kh + (_r0 + kr1) * KVC + kq1 * 8); ks2 = *(const bf16x8*)(Kh + (_r0 + kr2) * KVC + kq2 * 8); } while (0)
#define SWRITE(bb) do { *(LAS bf16x8*)(V_lds + (bb) * SHM_V + vst0) = vs0; *(LAS bf16x8*)(V_lds + (bb) * SHM_V + vst1) = vs1; \
    *(LAS bf16x8*)(K_lds + (bb) * SHM_K + kst0) = ks0; *(LAS bf16x8*)(K_lds + (bb) * SHM_K + kst1) = ks1; *(LAS bf16x8*)(K_lds + (bb) * SHM_K + kst2) = ks2; } while (0)
#define QKT(pp0, pp1, bb) qkt(pp0, pp1, K_lds + (bb) * SHM_K, qr, r32, hi)
#endif
    f32x16 p0, p1; float mn, al; bf16x8 pa0, pa1, pa2, pa3;
#if FP8_QK && FP8_PV
    i32x4a vA, kA0, kA1, vB, kB0, kB1;
    const int kr1c = k1ok ? kr1 : kr0, kq1c = k1ok ? kq1 : kq0;
#define SLOADX(V, K0, K1, j) do { const int jj_ = (j) < NT ? (j) : NT - 1; const size_t _r0 = (size_t)TROW(jj_); V = *(const i32x4a*)(Vt8 + (size_t)jj_ * 8192); \
    K0 = *(const i32x4a*)(Kh8 + (_r0 + kr0) * (KVC * 2) + kq0 * 16); K1 = *(const i32x4a*)(Kh8 + (_r0 + kr1c) * (KVC * 2) + kq1c * 16); } while (0)
#define SWRITEX(bb, V, K0, K1) do { *(LAS i32x4a*)(V_lds + (bb) * 8192 + tid * 16) = V; \
    *(LAS i32x4a*)(K_lds + (bb) * SHM_K8 + kst0) = K0; if (k1ok) *(LAS i32x4a*)(K_lds + (bb) * SHM_K8 + kst1) = K1; } while (0)
#define TMATH(j, slot) do { \
        qkt8(p0, p1, K_lds + (slot) * SHM_K8, q8, r32, hi, PSHIFT - m_reg); \
        partialSM8(p0, p1, m_reg, al, (j) == 0); \
        if (__any(al < 1.f)) { if (hi == 0) al_l[r32] = al; asm volatile("s_waitcnt lgkmcnt(0)" ::: "memory"); \
            _Pragma("unroll") for (int d = 0; d < 4; ++d) _Pragma("unroll") for (int r = 0; r < 16; ++r) o[d][r] *= al_l[crow(r, hi)]; } \
        finishSM8(p0, p1, al, l_reg); \
        pv8(o, V_lds + (slot) * 8192, p0, p1, r32, hi); } while (0)
#define APAIR(j, s0, s1, w0, w1) do {     \
        SLOADX(vA, kA0, kA1, (j) + 2); SBAR(); \
        TMATH(j, s0); \
        if ((j) + 2 < NT) SWRITEX(w0, vA, kA0, kA1); \
        SLOADX(vA, kA0, kA1, (j) + 3); SBAR(); \
        TMATH((j) + 1, s1); \
        if ((j) + 2 < NT) SWRITEX(w1, vA, kA0, kA1); \
        __syncthreads(); } while (0)
    SLOADX(vA, kA0, kA1, 0); SLOADX(vB, kB0, kB1, 1);
    SWRITEX(0, vA, kA0, kA1); SWRITEX(1, vB, kB0, kB1); __syncthreads();
    for (int j = 0; j < NT; j += 4) {
        APAIR(j, 0, 1, 2, 3);
        APAIR(j + 2, 2, 3, 0, 1);
    }
#undef TMATH
#undef APAIR
#define ATILE 0
#undef SLOADX
#undef SWRITEX
#undef ATILE
#else
    SLOAD(0); asm volatile("s_waitcnt vmcnt(0)" ::: "memory"); SWRITE(0); __syncthreads();
    for (int j = 0; j < NT; ++j) {
        const int bb = j & 1;
        if (j + 1 < NT) SLOAD(j + 1);
        SBAR();
        QKT(p0, p1, bb);
        partialSM(p0, p1, m_reg, mn, al);
        if (__any(al < 1.f)) { if (hi == 0) al_l[r32] = al; asm volatile("s_waitcnt lgkmcnt(0)" ::: "memory");
#pragma unroll
            for (int d = 0; d < 4; ++d)
#pragma unroll
                for (int r = 0; r < 16; ++r) o[d][r] *= al_l[crow(r, hi)]; }
        finishSM(p0, p1, al, l_reg, pa0, pa1, pa2, pa3); SBAR();
        pv_d0(o, vb0 + bb * SHM_V, pa0, pa1, pa2, pa3);
        if (j + 1 < NT) { asm volatile("s_waitcnt vmcnt(0)" ::: "memory"); SWRITE(bb ^ 1); }
        __syncthreads();
    }
#endif
#if FP8_QK && FP8_PV
    asm volatile("s_nop 15\n\ts_nop 7" : "+v"(o[0]), "+v"(o[1]), "+v"(o[2]), "+v"(o[3]));
#endif
    if (hi == 0) li_l[r32] = l_reg; asm volatile("s_waitcnt lgkmcnt(0)" ::: "memory");
    float rli[16];
#pragma unroll
    for (int r = 0; r < 16; ++r) rli[r] = __builtin_amdgcn_rcpf(li_l[crow(r, hi)]);
    if constexpr (OUT8) { unsigned char* Ow = (unsigned char*)CAT + (size_t)(qrow0 + wid * 32) * DM + 1280 + h * 128;
#pragma unroll
        for (int r = 0; r < 16; ++r) { const int orow = crow(r, hi);
#pragma unroll
            for (int d0 = 0; d0 < 4; ++d0) Ow[(size_t)orow * DM + d0 * 32 + r32] = (unsigned char)(pack4_fp8(o[d0][r] * rli[r], 0.f, 0.f, 0.f) & 0xffu); } }
    else { bf16_t* Ow = CAT + (size_t)(qrow0 + wid * 32) * DM + 1280 + h * 128;
#pragma unroll
        for (int r = 0; r < 16; ++r) { const int orow = crow(r, hi);
#pragma unroll
            for (int d0 = 0; d0 < 4; ++d0) Ow[(size_t)orow * DM + d0 * 32 + r32] = f2bf(o[d0][r] * rli[r]); } }
#undef TROW
#undef SLOAD
#undef SWRITE
#undef QKT
}
#undef KSWZ
#undef KSWZ8
#undef SBAR
}
template <bool OUT8>
__device__ __forceinline__ void phase_attn(Frame& F, int layer) {
    const bf16_t* QR = WSP(bf16_t, WS_QR); const bf16_t* KV = WSP(bf16_t, WS_KVR); bf16_t* CAT = WSP(bf16_t, WS_CAT);
    const int nunits = 768 + (layer == 0 ? 96 : 0);
    for (int uu_ = F.bid; uu_ < nunits * ATT_REP; uu_ += F.G) {
        const int u = uu_ % nunits;
        int b, h, qrow0, NT;
        if (u < 768) { int v = u;
            if (F.G == 256) { const int x = F.bid & 7, jx = F.bid >> 3, r = u >> 8; v = (((r * 8 + x) * 4 + (jx >> 3)) << 3) + (jx & 7); }
            b = v / 48; h = (v % 48) >> 3; qrow0 = b * SEQ + (v & 7) * 256; NT = 36; }
        else { const int uu = u - 768; b = uu / 6; h = uu % 6; qrow0 = TL + b * CTXL; NT = 4; }
        __syncthreads();
        attn::attn_unit<OUT8>(QR, KV, F.ws + WS_VT8, CAT, qrow0, b, h, NT, F.lds);
    }
    __syncthreads();
}

__device__ __forceinline__ void phase_moe_lists(Frame& F) {
    const int NGW = F.G * NWAVES, first = F.bid * NWAVES, tid = F.tid, lane = F.lane, w = F.wave;
    LAS int* red = (LAS int*)F.lds;
    LAS int* tot = red + 128;
    LAS int* wbase = tot + 16;
    const int* cntw = WSP(int, WS_SMALL + SM_CNTW); const int* topi = WSP(int, WS_SMALL + SM_TOPI); const float* topw = WSP(float, WS_SMALL + SM_TOPW);
    int* rowtok = WSP(int, WS_SMALL + SM_ROWTOK); float* roww = WSP(float, WS_SMALL + SM_ROWW); int* tilee = WSP(int, WS_SMALL + SM_TILEE); int* pos = WSP(int, WS_SMALL + SM_POS);
    int tl[8], pl[8];
#pragma unroll
    for (int e = 0; e < 8; ++e) { tl[e] = 0; pl[e] = 0; }
    for (int g = tid; g < NGW; g += NTHR) { const int4 a = *(const int4*)(cntw + (size_t)g * 8), b = *(const int4*)(cntw + (size_t)g * 8 + 4); const int m = g < first ? 1 : 0;
        tl[0] += a.x; tl[1] += a.y; tl[2] += a.z; tl[3] += a.w; tl[4] += b.x; tl[5] += b.y; tl[6] += b.z; tl[7] += b.w;
        pl[0] += m * a.x; pl[1] += m * a.y; pl[2] += m * a.z; pl[3] += m * a.w; pl[4] += m * b.x; pl[5] += m * b.y; pl[6] += m * b.z; pl[7] += m * b.w; }
#pragma unroll
    for (int e = 0; e < 8; ++e) {
#pragma unroll
        for (int o = 1; o < 64; o <<= 1) { tl[e] += __shfl_xor(tl[e], o); pl[e] += __shfl_xor(pl[e], o); }
        if (lane == 0) { red[w * 16 + e] = tl[e]; red[w * 16 + 8 + e] = pl[e]; } }
    __syncthreads();
    if (tid < 16) { int sum = 0;
#pragma unroll
        for (int k = 0; k < 8; ++k) sum += red[k * 16 + tid];
        tot[tid] = sum; }
    __syncthreads();
    if (tid < 64) { const int ww = tid >> 3, e = tid & 7; int sum = tot[8 + e]; for (int k = 0; k < ww; ++k) sum += cntw[(size_t)(first + k) * 8 + e]; wbase[ww * 8 + e] = sum; }
    __syncthreads();
    int off[9]; { int o = 0;
#pragma unroll
        for (int e = 0; e < 8; ++e) { off[e] = o; o += (tot[e] + 255) & ~255; } off[8] = o; }
    { const int gw = first + w, r = gw + NGW * lane; const bool ok = r < TL;
      int e0 = -1, e1 = -1; float w0 = 0.f, w1 = 0.f;
      if (ok) { e0 = topi[2 * r]; e1 = topi[2 * r + 1]; w0 = topw[2 * r]; w1 = topw[2 * r + 1]; }
      const unsigned long long below = (1ull << lane) - 1ull; int p0 = 0, p1 = 0;
#pragma unroll
      for (int e = 0; e < 8; ++e) { const unsigned long long m0 = __ballot(e0 == e), m1 = __ballot(e1 == e);
          const int before = __popcll(m0 & below) + __popcll(m1 & below), base = off[e] + wbase[w * 8 + e];
          if (e0 == e) p0 = base + before; if (e1 == e) p1 = base + before; }
      if (ok) { rowtok[p0] = r; roww[p0] = w0; pos[2 * r] = p0; rowtok[p1] = r; roww[p1] = w1; pos[2 * r + 1] = p1; }
#if FP8_MOE_GU
      { const unsigned char* U8 = F.ws + WS_U; unsigned char* VP = F.ws + WS_VP8;
        for (int k4 = 0; k4 < 64; k4 += 4) { if (gw + NGW * k4 >= TL) break;
            u32x4 a[4], b[4]; float rsv[4] = {0.f, 0.f, 0.f, 0.f};
#pragma unroll
            for (int i = 0; i < 4; ++i) { const int rk = gw + NGW * (k4 + i), rc = rk < TL ? rk : gw;
                a[i] = *(const u32x4*)(U8 + (size_t)rc * DM + lane * 16); b[i] = *(const u32x4*)(U8 + (size_t)rc * DM + 1024 + lane * 16);
                if (I8_MOE_GU != 0) rsv[i] = WSP(float, WS_SMALL + SM_RS)[rc]; }
#pragma unroll
            for (int i = 0; i < 4; ++i) { const int rk = gw + NGW * (k4 + i); const int q0 = __shfl(p0, k4 + i), q1 = __shfl(p1, k4 + i);
                if (rk < TL) {
                    if (I8_MOE_GU != 0 && lane == 0) { WSP(float, WS_SMALL + SM_VPS)[q0] = rsv[i]; WSP(float, WS_SMALL + SM_VPS)[q1] = rsv[i]; }
                    const f32x4 af = __builtin_bit_cast(f32x4, a[i]), bf = __builtin_bit_cast(f32x4, b[i]);
                    *(f32x4*)(VP + (size_t)q0 * DM + lane * 16) = af; *(f32x4*)(VP + (size_t)q0 * DM + 1024 + lane * 16) = bf;
                    *(f32x4*)(VP + (size_t)q1 * DM + lane * 16) = af; *(f32x4*)(VP + (size_t)q1 * DM + 1024 + lane * 16) = bf; } } } }
#endif
    }
    if (F.bid < 8) { const int e = F.bid; int lo_ = 0, hi_ = 0;
#pragma unroll
        for (int k = 0; k < 8; ++k) if (k == e) { lo_ = off[k] + tot[k]; hi_ = off[k + 1]; }
        for (int p = lo_ + tid; p < hi_; p += NTHR) { rowtok[p] = -1; roww[p] = 0.f; if (I8_MOE_GU != 0) WSP(float, WS_SMALL + SM_VPS)[p] = 0.f; } }
    if (F.bid == (8 % F.G)) { for (int t = tid; t < (off[8] >> 8); t += NTHR) { int e = 0;
#pragma unroll
            for (int k = 1; k < 8; ++k) if (t * 256 >= off[k]) e = k;
            tilee[t] = e; }
        if (tid == 0) tilee[300] = off[8] >> 8; }
    __syncthreads();
}

__device__ __forceinline__ void phase_moe_combine(Frame& F, const float* gateL) {
    const int gw = F.bid * NWAVES + F.wave, NGW = F.G * NWAVES, lane = F.lane;
    const bf16_t* PAIR = WSP(bf16_t, WS_PAIR); const int* pos = WSP(int, WS_SMALL + SM_POS); const float* topw = WSP(float, WS_SMALL + SM_TOPW);
    for (int r = gw; r < TL; r += NGW) {
        const int p0 = pos[2 * r], p1 = pos[2 * r + 1]; const float w0 = topw[2 * r], w1 = topw[2 * r + 1];
        const float* gate = gateL + (size_t)(r >> 11) * 12288;
        float* hrow = F.out + (size_t)r * DM; const bf16_t* h16 = WSP(bf16_t, WS_H16) + (size_t)r * DM;
        const bf16_t* a0 = PAIR + (size_t)p0 * DM; const bf16_t* a1 = PAIR + (size_t)p1 * DM;
#pragma unroll
        for (int j = 0; j < 8; ++j) { const int c = 256 * j + 4 * lane;
            const u32x2 x0 = *(const u32x2*)(a0 + c), x1 = *(const u32x2*)(a1 + c); const f32x4 g4 = *(const f32x4*)(gate + c); const u32x2 hw = *(const u32x2*)(h16 + c); f32x4 hv = (f32x4){bf_lo(hw.x), bf_hi(hw.x), bf_lo(hw.y), bf_hi(hw.y)};
            hv[0] += g4[0] * (w0 * bf_lo(x0.x) + w1 * bf_lo(x1.x)); hv[1] += g4[1] * (w0 * bf_hi(x0.x) + w1 * bf_hi(x1.x));
            hv[2] += g4[2] * (w0 * bf_lo(x0.y) + w1 * bf_lo(x1.y)); hv[3] += g4[3] * (w0 * bf_hi(x0.y) + w1 * bf_hi(x1.y));
            *(f32x4*)(hrow + c) = hv; }
    }
}

#ifdef DBG_ONLY
#define IN(k) ((((k) == 0 ? 0 : (((k) - 1) % 10) + 1) == DBG_ONLY || (DBG_ONLY >= 20 && (k) == DBG_ONLY - 9)) && lo <= (k) && (k) < hi)
#else
#define IN(k) (lo <= (k) && (k) < hi)
#endif
#define SEAM(k) do { if (IN(k) && IN((k) + 1)) xcd_barrier(bar); } while (0)
template <int L>
__device__ __forceinline__ void layer_program(Frame& F, const XcdBarrier& bar, const int lo, const int hi) {
        const int pb = 1 + 10 * L;
        const float* hLin = L == 0 ? F.in[0] : F.out; const float* hCin = L == 0 ? F.in[2] : WSP(float, WS_HC);
        const int nMall = L == 0 ? TT / 256 : TL / 256;
        const float* modL = WSP(float, WS_SMALL + SM_MODL) + (size_t)L * 16 * 12288; const float* modC = WSP(float, WS_SMALL + SM_MODC) + (size_t)L * 12288;
        if (IN(pb + 0)) for (int rep = 0; rep < NREP(pb + 0); ++rep) { phase_norm<false, (((I8_INPROJ >> L) & 1) ? 2 : ((L == 1 && FP8_INPROJ_L1 != 0) ? 1 : 0)), (L == 1)>(F, hLin, hCin, F.in[6] + L * DM, L, 0, TT);
            if constexpr (L == 0 && (I8_INPROJ & 1)) { __syncthreads(); win_i8_items(F, 0, F.bid * NWAVES + F.wave, F.G * NWAVES); } }
        SEAM(pb + 0);
        if (IN(pb + 1)) for (int rep = 0; rep < NREP(pb + 1); ++rep) { constexpr bool Q8 = ((I8_INPROJ >> L) & 1) != 0, F8 = (L == 1 && FP8_INPROJ_L1 != 0); constexpr int KU = (Q8 || F8) ? DM / 2 : DM, MD = Q8 ? 2 : (F8 ? 1 : 0);
            pg8::Gemm g{WSP(bf16_t, WS_U), WSP(bf16_t, WS_WIN) + (size_t)L * PC * DM, KU, KU};
            pg8::EpiBf16 E{WSP(bf16_t, WS_P), PC, F8 ? W8_INV : 1.0f}; pg8::EpiBf16Q EQ{WSP(bf16_t, WS_P), PC, WSP(float, WS_SMALL + SM_RS), WSP(float, WS_SMALL + SM_CS_WIN) + L * PC, FP8_UQKV ? F.ws + WS_C8 : nullptr};
            if constexpr (L == 0) { pg8::StaticOrder S; S.init(TT / 256, PC / 256, F.G, F.bid); S.rep = GREP(pb + 1);
                if constexpr (Q8) pg8::gemm_phase<pg8::EpiBf16Q, pg8::StaticOrder, MD>(F.lds, g, S, EQ); else pg8::gemm_phase<pg8::EpiBf16, pg8::StaticOrder, MD>(F.lds, g, S, E); }
            else { pg8::InProjL1Order S; S.init(F.G, F.bid);
                if constexpr (Q8) pg8::gemm_phase<pg8::EpiBf16Q, pg8::InProjL1Order, MD>(F.lds, g, S, EQ); else pg8::gemm_phase<pg8::EpiBf16, pg8::InProjL1Order, MD>(F.lds, g, S, E); } }
        SEAM(pb + 1);
        if (IN(pb + 2)) for (int rep = 0; rep < NREP(pb + 2); ++rep) {
            phase_conv_pool(F, L);
            __syncthreads();
            { constexpr bool F8 = FP8_UQKV != 0;
              pg8::Gemm g{F8 ? (const bf16_t*)(F.ws + WS_C8) : WSP(bf16_t, WS_P) + PCQ, WSP(bf16_t, WS_WUQ) + (size_t)L * QC * 512, F8 ? 512 : PC, F8 ? 256 : 512}; pg8::StaticOrder S; S.init(nMall, QC / 256, F.G, F.bid); S.rep = GREP(pb + 2);
              pg8::EpiBf16 E{WSP(bf16_t, WS_QR), QC, F8 ? W8_INV : 1.0f}; pg8::gemm_phase<pg8::EpiBf16, pg8::StaticOrder, F8 ? 1 : 0>(F.lds, g, S, E); }
            { constexpr bool F8 = FP8_UQKV != 0;
              pg8::Gemm g{F8 ? (const bf16_t*)(F.ws + WS_C8 + 512) : WSP(bf16_t, WS_P) + PCKV, WSP(bf16_t, WS_WUKV) + (size_t)L * KVC * 512, F8 ? 512 : PC, F8 ? 256 : 512}; pg8::StaticOrder S; S.init(TT / 256, KVC / 256, F.G, F.bid); S.rep = GREP(pb + 2);
              pg8::EpiBf16 E{WSP(bf16_t, WS_KVR), KVC, F8 ? W8_INV : 1.0f}; pg8::gemm_phase<pg8::EpiBf16, pg8::StaticOrder, F8 ? 1 : 0>(F.lds, g, S, E); }
        }
        SEAM(pb + 2);
        if (IN(pb + 3)) for (int rep = 0; rep < NREP(pb + 3); ++rep) {
            phase_ssd(F, L);
            { const int lightbase = F.G < NB * 24 ? NB * 24 - F.G : 0, nlight = F.G - lightbase;
              if (F.bid >= lightbase) { const int lw = (F.bid - lightbase) * NWAVES + F.wave, nlw = nlight * NWAVES;
                  if constexpr (L == 0 && I8_DENSE_GU != 0) { LAS float* scr = (LAS float*)(F.lds + F.wave * 16896);
                      for (int it = lw; it < 2 * 16 * 176; it += nlw) { const int up = it >= 16 * 176; tr_itemq(F.in[24 + up], 2048, FF, F.ws + WS_WGU, 3 + up, WSP(float, WS_SMALL + SM_CS_DGU), scr, it - up * 16 * 176, F.lane); } }
                  if constexpr (L == 0 && (I8_INPROJ & 2)) win_i8_items(F, 1, lw, nlw);
                  moe_weight_items(F, L == 0 ? 0 : MOE_PCT_B, L == 0 ? MOE_PCT_A : 100, lw, nlw); } }
            if (rep == 0) phase_qkv_final(F, L);
            __syncthreads();
            { pg8::Gemm g{WSP(bf16_t, WS_PL), WSP(bf16_t, WS_SMALL + SM_POOLB) + (size_t)L * 512 * 512, 512, 512}; pg8::StaticOrder S; S.init(nMall, 2, F.G, F.G - 1 - F.bid);
              if constexpr ((FP8_WOUT >> L) & 1) { pg8::EpiF8 E{F.ws + WS_CAT + 768, DM, 1.0f}; pg8::gemm_phase<pg8::EpiF8, pg8::StaticOrder>(F.lds, g, S, E); }
              else { pg8::EpiBf16 E{WSP(bf16_t, WS_CAT) + 768, DM}; pg8::gemm_phase<pg8::EpiBf16, pg8::StaticOrder>(F.lds, g, S, E); } }
        }
        SEAM(pb + 3);
        if (IN(pb + 4)) for (int rep = 0; rep < NREP(pb + 4); ++rep) { phase_attn<((FP8_WOUT >> L) & 1) != 0>(F, L); phase_ssd_gate<((FP8_WOUT >> L) & 1) != 0>(F, L, nMall * 256); }
        SEAM(pb + 4);
        if (IN(pb + 5)) for (int rep = 0; rep < NREP(pb + 5); ++rep) { constexpr bool F8 = ((FP8_WOUT >> L) & 1) != 0; constexpr int KU = F8 ? DM / 2 : DM;
            pg8::Gemm g{WSP(bf16_t, WS_CAT), WSP(bf16_t, WS_WOUT) + (size_t)L * DM * DM, KU, KU}; pg8::StaticOrder S; S.init(nMall, DM / 256, F.G, F.bid); S.rep = GREP(pb + 5);
            pg8::EpiResid16<L == 0> E{F.in[0], F.in[2], WSP(bf16_t, WS_H16), modL + 2 * DM, modC + 2 * DM, F8 ? W8_INV : 1.0f}; pg8::gemm_phase<pg8::EpiResid16<L == 0>, pg8::StaticOrder, F8 ? 1 : 0>(F.lds, g, S, E);
            if constexpr (L == 0) { const int full = (nMall * (DM / 256)) % F.G;
                if (rep == 0 && full != 0 && F.bid >= full) moe_weight_items(F, MOE_PCT_A, MOE_PCT_W, (F.bid - full) * NWAVES + F.wave, (F.G - full) * NWAVES); } }
        SEAM(pb + 5);
        if (IN(pb + 6)) for (int rep = 0; rep < NREP(pb + 6); ++rep) { if constexpr (L == 0) phase_norm<false, (I8_DENSE_GU ? 2 : (FP8_DENSE_GU ? 1 : 0)), true>(F, nullptr, nullptr, F.in[7] + L * DM, L, 3, TT); else phase_norm<true, (I8_MOE_GU ? 2 : (FP8_MOE_GU ? 1 : 0)), true>(F, nullptr, nullptr, F.in[7] + L * DM, L, 3, TL); }
        SEAM(pb + 6);
        if constexpr (L == 0) {
            if (IN(pb + 7) && !IN(pb + 6) && IN(pb + 8)) xcd_barrier(bar);
            if (IN(pb + 8)) for (int rep = 0; rep < NREP(pb + 8); ++rep) { constexpr bool Q8 = I8_DENSE_GU != 0, F8 = FP8_DENSE_GU != 0, O8 = FP8_DENSE_DN != 0; constexpr int KU = (Q8 || F8) ? DM / 2 : DM;
                pg8::Gemm g{WSP(bf16_t, WS_U), WSP(bf16_t, WS_WGU), KU, KU}; pg8::StaticOrder S; S.init(TT / 256, 2 * FF / 256, F.G, F.bid); S.rep = GREP(pb + 8);
                if constexpr (Q8) { pg8::EpiGateUpQ<O8> E{F.ws + WS_HID, FF, WSP(float, WS_SMALL + SM_RS), WSP(float, WS_SMALL + SM_CS_DGU)}; E.nkt = (HID_BLOCKED && O8) ? FF / 128 : 0; pg8::gemm_phase<pg8::EpiGateUpQ<O8>, pg8::StaticOrder, 2>(F.lds, g, S, E); }
                else { pg8::EpiGateUp<O8> E{F.ws + WS_HID, FF, F8 ? W8_INV : 1.0f}; E.nkt = (HID_BLOCKED && O8) ? FF / 128 : 0; pg8::gemm_phase<pg8::EpiGateUp<O8>, pg8::StaticOrder, F8 ? 1 : 0>(F.lds, g, S, E); } }
            SEAM(pb + 8);
            if (IN(pb + 9)) for (int rep = 0; rep < NREP(pb + 9); ++rep) { constexpr bool F8 = FP8_DENSE_DN != 0; constexpr int KU = F8 ? FF / 2 : FF;
                pg8::Gemm g{WSP(bf16_t, WS_HID), WSP(bf16_t, WS_WDN), (HID_BLOCKED && F8) ? 64 : KU, KU}; if (HID_BLOCKED && F8) { g.akstep = 256 * 128; g.atile = (size_t)(FF / 128) * 256 * 128; } pg8::StaticOrder S; S.init(TT / 256, DM / 256, F.G, F.bid);
                pg8::EpiResid16<false> E{nullptr, nullptr, WSP(bf16_t, WS_H16), modL + 5 * DM, modC + 5 * DM, F8 ? W8_INV : 1.0f}; pg8::gemm_phase<pg8::EpiResid16<false>, pg8::StaticOrder, F8 ? 1 : 0>(F.lds, g, S, E);
                { const int nu = (TT / 256) * (DM / 256), full = nu % F.G;
                  if (rep == 0 && full != 0 && F.bid >= full) moe_weight_items(F, MOE_PCT_W, MOE_PCT_B, (F.bid - full) * NWAVES + F.wave, (F.G - full) * NWAVES); } }
            SEAM(pb + 9);
        } else {
            if (IN(pb + 7)) for (int rep = 0; rep < NREP(pb + 7); ++rep) phase_moe_lists(F);
            SEAM(pb + 7);
            const int* tilee = WSP(int, WS_SMALL + SM_TILEE);
            if (IN(pb + 8)) for (int rep = 0; rep < NREP(pb + 8); ++rep) { const int ntiles = tilee[300];
                constexpr bool Q8 = I8_MOE_GU != 0, F8 = FP8_MOE_GU != 0; constexpr int KU = (Q8 || F8) ? DM / 2 : DM;
                pg8::Gemm g{(Q8 || F8) ? (const bf16_t*)(F.ws + WS_VP8) : WSP(bf16_t, WS_U), WSP(bf16_t, WS_MWGU), KU, KU}; pg8::MoeOrder S; S.init(ntiles, 2 * FF / 256, F.G, F.bid); S.tile_e = tilee; S.rowtok = WSP(int, WS_SMALL + SM_ROWTOK); S.rows_per_expert = 2 * FF;
                if constexpr (Q8) { pg8::EpiGateUpQ<FP8_MOE_DN != 0> E{F.ws + WS_HID, FF, WSP(float, WS_SMALL + SM_VPS), WSP(float, WS_SMALL + SM_CS_MGU), tilee, 2 * FF}; E.nkt = (HID_BLOCKED && FP8_MOE_DN) ? FF / 128 : 0; pg8::gemm_phase<pg8::EpiGateUpQ<FP8_MOE_DN != 0>, pg8::MoeOrder, 2>(F.lds, g, S, E); }
                else { pg8::EpiGateUp<FP8_MOE_DN != 0> E{F.ws + WS_HID, FF, F8 ? W8_INV : 1.0f}; E.nkt = (HID_BLOCKED && FP8_MOE_DN) ? FF / 128 : 0; pg8::gemm_phase<pg8::EpiGateUp<FP8_MOE_DN != 0>, pg8::MoeOrder, F8 ? 1 : 0>(F.lds, g, S, E); } }
            SEAM(pb + 8);
            if (IN(pb + 9)) for (int rep = 0; rep < NREP(pb + 9); ++rep) { const int ntiles = tilee[300];
                constexpr bool F8 = FP8_MOE_DN != 0; constexpr int KU = F8 ? FF / 2 : FF;
                pg8::Gemm g{WSP(bf16_t, WS_HID), WSP(bf16_t, WS_MWDN), (HID_BLOCKED && F8) ? 64 : KU, KU}; if (HID_BLOCKED && F8) { g.akstep = 256 * 128; g.atile = (size_t)(FF / 128) * 256 * 128; } pg8::MoeOrder S; S.init(ntiles, DM / 256, F.G, F.bid); S.tile_e = tilee; S.rowtok = WSP(int, WS_SMALL + SM_ROWTOK); S.rows_per_expert = DM;
                pg8::EpiBf16 E{WSP(bf16_t, WS_PAIR), DM, F8 ? W8_INV : 1.0f}; pg8::gemm_phase<pg8::EpiBf16, pg8::MoeOrder, F8 ? 1 : 0>(F.lds, g, S, E); }
            SEAM(pb + 9);
            if (IN(pb + 10)) phase_moe_combine(F, modL + 5 * DM);
        }
}
constexpr int NPH = 22;
__global__ void __launch_bounds__(NTHR, 2) mega(Args args) {
    extern __shared__ __attribute__((aligned(16))) unsigned char lds_raw[];
    Frame F;
    F.lds = (LAS unsigned char*)lds_raw; F.tid = threadIdx.x; F.lane = F.tid & 63; F.wave = __builtin_amdgcn_readfirstlane(F.tid >> 6); F.G = gridDim.x; F.bid = blockIdx.x;
    F.in = args.in; F.out = args.out; F.ws = args.ws;
    volatile LAS unsigned* MISC = (volatile LAS unsigned*)(F.lds + LDSCTL_OFF);
    if (F.tid < 64) MISC[F.tid] = 0u;
    __syncthreads();
    const int lo = args.ph_lo, hi = args.ph_hi;
    XcdBarrier bar; bar.bar = (unsigned*)(F.ws + WS_CTL) + CW_BAR; bar.x = 0; bar.st = nullptr;
    if (hi - lo > 1) bar = xcd_barrier_post((unsigned*)(F.ws + WS_CTL) + CW_BAR, MISC + 8);
    if (IN(0)) for (int rep = 0; rep < NREP(0); ++rep) { __syncthreads(); p0_prologue(F); }
    SEAM(0);
    layer_program<0>(F, bar, lo, hi);
    layer_program<1>(F, bar, lo, hi);
#undef IN
#undef SEAM
}

extern "C" void kernel_launch(void* const* d_in, const int* in_sizes, int n_in, void* d_out, int out_size, void* d_ws, size_t ws_size, hipStream_t stream) {
    static int grid = 0;
    if (grid == 0) {
        if (n_in != 31 || out_size != TL * DM || ws_size < WS_END) { fprintf(stderr, "kernel_launch: unexpected shapes (n_in %d, out %d, ws %zu < %zu)\n", n_in, out_size, ws_size, (size_t)WS_END); grid = -1; return; }
        int dev = 0, cus = 0;
        if (hipGetDevice(&dev) != hipSuccess || hipDeviceGetAttribute(&cus, hipDeviceAttributeMultiprocessorCount, dev) != hipSuccess) { grid = -1; return; }
        if (hipFuncSetAttribute((const void*)mega, hipFuncAttributeMaxDynamicSharedMemorySize, LDS_BYTES) != hipSuccess) { fprintf(stderr, "kernel_launch: hipFuncSetAttribute failed\n"); grid = -1; return; }
        grid = cus;
    }
    if (grid < 0) return;
    (void)hipMemsetAsync((char*)d_ws + WS_CTL, 0, CTL_BYTES, stream);
    Args a{};
    for (int i = 0; i < 31; ++i) a.in[i] = (const float*)d_in[i];
    a.out = (float*)d_out; a.ws = (unsigned char*)d_ws;
#if MK_N_LAUNCHES == 1
    a.ph_lo = 0; a.ph_hi = NPH;
    hipLaunchKernelGGL(mega, dim3(grid), dim3(NTHR), LDS_BYTES, stream, a);
#else
    for (int ph = 0; ph < NPH; ++ph) { if (ph == 8) continue; a.ph_lo = ph; a.ph_hi = ph + 1; hipLaunchKernelGGL(mega, dim3(grid), dim3(NTHR), LDS_BYTES, stream, a); }
#endif
}
```

```cpp
#include <hip/hip_runtime.h>
#include <cstdio>
#include <cstdint>

#ifndef MK_N_LAUNCHES
#define MK_N_LAUNCHES 1
#endif

#ifndef DUP_PHASE
#define DUP_PHASE (-1)
#endif
#define NREP(k) (((k) == DUP_PHASE) ? 2 : 1)
#ifndef FP8_MOE_GU
#define FP8_MOE_GU 1
#endif
#ifndef FP8_MOE_DN
#define FP8_MOE_DN 1
#endif
#ifndef FP8_DENSE_GU
#define FP8_DENSE_GU 1
#endif
#ifndef FP8_DENSE_DN
#define FP8_DENSE_DN 1
#endif
#ifndef I8_DENSE_GU
#define I8_DENSE_GU 1
#endif
#ifndef FP8_QK
#define FP8_QK 1
#endif
#ifndef FP8_UQKV
#define FP8_UQKV 1
#endif
#ifndef FP8_PV
#define FP8_PV 1
#endif
#ifndef FP8_WOUT
#define FP8_WOUT 2
#endif
#ifndef I8_MOE_GU
#define I8_MOE_GU 1
#endif
#ifndef I8_INPROJ
#define I8_INPROJ 3
#endif
#ifndef FP8_INPROJ_L1
#define FP8_INPROJ_L1 0
#endif
#ifndef GEMM_DUP_PHASE
#define GEMM_DUP_PHASE (-1)
#endif
#define GREP(k) (((k) == GEMM_DUP_PHASE) ? 2 : 1)
#ifndef GEMM_STAGGER
#define GEMM_STAGGER 0
#endif
#ifndef MOE_PCT_A
#define MOE_PCT_A 25
#define MOE_PCT_W 37
#define MOE_PCT_B 62
#endif
#ifndef ATT_REP
#define ATT_REP 1
#endif
#ifndef SSD_TOUCH
#define SSD_TOUCH 0
#endif
#ifndef SSD_PROBE
#define SSD_PROBE 0
#endif
#ifndef HID_BLOCKED
#define HID_BLOCKED 1
#endif
#ifndef SSD_REP
#define SSD_REP 1
#endif
#define LAS __attribute__((address_space(3)))
#if FP8_QK && FP8_PV
#define ATT_QKFOLD 0.32267548f
#else
#define ATT_QKFOLD 1.0f
#endif
#define GAS __attribute__((address_space(1)))
typedef unsigned short bf16_t;
typedef short bf16x8 __attribute__((ext_vector_type(8)));
typedef float f32x4 __attribute__((ext_vector_type(4)));
typedef float f32x2 __attribute__((ext_vector_type(2)));
typedef unsigned u32x4 __attribute__((ext_vector_type(4)));
typedef unsigned u32x2 __attribute__((ext_vector_type(2)));
typedef int i32x4 __attribute__((ext_vector_type(4)));
typedef int i32x8 __attribute__((ext_vector_type(8)));

constexpr int DM = 2048, NB = 16, SEQ = 2048, CTXL = 256;
constexpr int TL = NB * SEQ, TC = NB * CTXL, TT = TL + TC;
constexpr int FF = 5632, NE = 8;
constexpr int D_IN = 3672;
constexpr int PC = 3840, PZ = 0, PXBC = 768, PPOOL = 2048, PCQ = 2560, PCKV = 3072, PKR = 3584, PDT = 3648;
constexpr int XAC = 1280;
constexpr int QC = 1280;
constexpr int KVC = 2048;
constexpr int NPMAX = 69632;
constexpr float EPS = 1e-6f;

constexpr size_t MiB = 1u << 20;
constexpr size_t WS_CTL = 0, CTL_BYTES = 1 * MiB;
constexpr size_t WS_SMALL = 1 * MiB;
constexpr size_t SM_MODL = 0;
constexpr size_t SM_MODC = 1572864;
constexpr size_t SM_ROPE = 1671168;
constexpr size_t SM_POOLB = 1679360;
constexpr size_t SM_TOPI = 2727936;
constexpr size_t SM_TOPW = 2990080;
constexpr size_t SM_ROWTOK = 3252224;
constexpr size_t SM_ROWW = 3530752;
constexpr size_t SM_TILEE = 3809280;
constexpr size_t SM_POS = 3811328;
constexpr size_t SM_CNTW = 4073472;
constexpr size_t SM_DT = 4 * MiB;
constexpr size_t SM_RS = 8 * MiB;
constexpr size_t SM_CS_DGU = SM_RS + 256 * 1024;
constexpr size_t SM_CS_WIN = SM_CS_DGU + 64 * 1024;
constexpr size_t SM_CS_MGU = SM_CS_WIN + 64 * 1024;
constexpr size_t SM_VPS = SM_CS_MGU + 512 * 1024;
constexpr size_t WS_WIN = 13 * MiB;
constexpr size_t WS_WOUT = WS_WIN + 30 * MiB;
constexpr size_t WS_WGU = WS_WOUT + 16 * MiB;
constexpr size_t WS_WDN = WS_WGU + 44 * MiB;
constexpr size_t WS_HC = WS_WDN + 22 * MiB;
constexpr size_t WS_U = WS_HC + 32 * MiB;
constexpr size_t WS_XA = WS_U, WS_PL = WS_U + 96 * MiB;
constexpr size_t WS_PAIR = WS_WIN;
constexpr size_t WS_WUQ = WS_U + 144 * MiB;
constexpr size_t WS_WUKV = WS_WUQ + 3 * MiB;
constexpr size_t WS_MWGU = WS_WUKV + 4 * MiB;
constexpr size_t WS_MWDN = WS_MWGU + 352 * MiB;
constexpr size_t WS_R = WS_MWDN + 176 * MiB;
constexpr size_t WS_P = WS_R;
constexpr size_t WS_QR = WS_P + 270 * MiB;
constexpr size_t WS_KVR = WS_QR + 90 * MiB;
constexpr size_t WS_YF = WS_KVR + 144 * MiB;
constexpr size_t WS_YB = WS_YF + 54 * MiB;
constexpr size_t WS_CAT = WS_YB + 54 * MiB;
constexpr size_t WS_VP8 = WS_WIN;
constexpr size_t WS_C8 = WS_YF;
constexpr size_t WS_HID = WS_R;
constexpr size_t WS_H16 = WS_R + 756 * MiB;
constexpr size_t WS_VT8 = WS_H16 + 144 * MiB;
constexpr size_t WS_END = WS_VT8 + 28 * MiB;
static_assert(WS_PAIR + (size_t)NPMAX * DM * 2 <= WS_U + 144 * MiB, "PAIR overlay");
static_assert(WS_VP8 + (size_t)NPMAX * DM <= WS_U, "VP8 overlay must stay clear of U (read while VP8 is written)");
static_assert(WS_HID + (size_t)NPMAX * FF * 2 <= WS_H16 && WS_CAT + (size_t)TT * DM * 2 <= WS_H16, "region R");
constexpr int CW_BAR = 4096;

__device__ __forceinline__ unsigned cvt_pk_bf16(float lo, float hi) { unsigned r; asm volatile("v_cvt_pk_bf16_f32 %0, %1, %2" : "=v"(r) : "v"(lo), "v"(hi)); return r; }
__device__ __forceinline__ float bf_lo(unsigned w) { return __uint_as_float(w << 16); }
__device__ __forceinline__ float bf_hi(unsigned w) { return __uint_as_float(w & 0xffff0000u); }
__device__ __forceinline__ float bf2f(bf16_t b) { return __uint_as_float(((unsigned)b) << 16); }
__device__ __forceinline__ bf16_t f2bf(float f) { return (bf16_t)(cvt_pk_bf16(f, 0.f) & 0xffffu); }
__device__ __forceinline__ unsigned pack4_fp8(float a, float b, float c, float d) {
    a = __builtin_amdgcn_fmed3f(a, -448.f, 448.f); b = __builtin_amdgcn_fmed3f(b, -448.f, 448.f); c = __builtin_amdgcn_fmed3f(c, -448.f, 448.f); d = __builtin_amdgcn_fmed3f(d, -448.f, 448.f);
    int w = 0; w = __builtin_amdgcn_cvt_pk_fp8_f32(a, b, w, false); w = __builtin_amdgcn_cvt_pk_fp8_f32(c, d, w, true); return (unsigned)w;
}
__device__ __forceinline__ unsigned pack4_i8(float a, float b, float c, float d) {
    unsigned w = 0;
    w = __builtin_amdgcn_cvt_pk_u8_f32(rintf(a + 128.f), 0, w); w = __builtin_amdgcn_cvt_pk_u8_f32(rintf(b + 128.f), 1, w);
    w = __builtin_amdgcn_cvt_pk_u8_f32(rintf(c + 128.f), 2, w); w = __builtin_amdgcn_cvt_pk_u8_f32(rintf(d + 128.f), 3, w);
    return w ^ 0x80808080u;
}
constexpr float W8_SCALE = 256.0f, W8_INV = 1.0f / 256.0f;
__device__ __forceinline__ float wave_sum(float v) {
#pragma unroll
    for (int o = 1; o < 64; o <<= 1) v += __shfl_xor(v, o);
    return v;
}
__device__ __forceinline__ float silu_f(float x) { return x * __builtin_amdgcn_rcpf(1.0f + __expf(-x)); }
#define LDS_WAIT() asm volatile("s_waitcnt lgkmcnt(0)" ::: "memory")
#define VM_WAIT() asm volatile("s_waitcnt vmcnt(0)" ::: "memory")

#define XB_TMO      128
#define XB_XCNT(j)  (256  + 64 * (j))
#define XB_XSUB(j)  (1280 + 64 * (j))
#define XB_XGEN(j)  (2304 + 64 * (j))
#define XB_TOP      3328
#define XB_TOPGEN   3392
#define XCD_BAR_WORDS 3456
#define XB_SPIN_CAP (1u << 20)
__device__ __forceinline__ unsigned xb_ld(unsigned* p)              { return __hip_atomic_load(p, __ATOMIC_RELAXED, __HIP_MEMORY_SCOPE_AGENT); }
__device__ __forceinline__ unsigned xb_add(unsigned* p, unsigned v) { return __hip_atomic_fetch_add(p, v, __ATOMIC_RELAXED, __HIP_MEMORY_SCOPE_AGENT); }
__device__ __forceinline__ unsigned xb_xcc_id() { return (unsigned)__builtin_amdgcn_s_getreg((3 << 11) | 20) & 0xFu; }
#define XB_SPIN(cond, bar) do { unsigned _sp = 0; while (cond) { __builtin_amdgcn_s_sleep(1); \
    if ((++_sp & 255u) == 0u) { if (xb_ld(&(bar)[XB_TMO])) break; if (_sp > XB_SPIN_CAP) { atomicAdd(&(bar)[XB_TMO], 1u); break; } } } } while (0)
struct XcdBarrier { unsigned* bar; unsigned x; volatile LAS unsigned* st; };
__device__ __forceinline__ XcdBarrier xcd_barrier_post(unsigned* bar, volatile LAS unsigned* st) {
    XcdBarrier b; b.bar = bar; b.x = xb_xcc_id(); b.st = st;
    if (threadIdx.x == 0) (void)xb_add(&bar[XB_XCNT(b.x)], 1u);
    return b;
}
__device__ __forceinline__ void xcd_barrier_complete(unsigned* bar, unsigned x, unsigned& nloc, unsigned& nx) {
    const unsigned G = gridDim.x * gridDim.y * gridDim.z;
    unsigned sum, cnt, mine, sp = 0u;
    for (;;) {
        sum = 0u; cnt = 0u; mine = 0u;
#pragma unroll
        for (unsigned j = 0; j < 16; ++j) { const unsigned c = xb_ld(&bar[XB_XCNT(j)]); sum += c; cnt += (c > 0u) ? 1u : 0u; mine = (j == x) ? c : mine; }
        if (sum == G) break;
        __builtin_amdgcn_s_sleep(1);
        if ((++sp & 255u) == 0u) { if (xb_ld(&bar[XB_TMO])) break; if (sp > XB_SPIN_CAP) { atomicAdd(&bar[XB_TMO], 1u); break; } }
    }
    nloc = mine > 0u ? mine : 1u; nx = cnt > 0u ? cnt : 1u;
}
__device__ __forceinline__ void xcd_barrier(const XcdBarrier& b) {
    asm volatile("s_waitcnt vmcnt(0)" ::: "memory");
    __syncthreads();
    if (threadIdx.x == 0) {
        unsigned* bar = b.bar;
        __builtin_amdgcn_s_waitcnt(0);
        unsigned nloc = b.st[0], nx = b.st[1];
        if (nloc == 0u) { xcd_barrier_complete(bar, b.x, nloc, nx); b.st[0] = nloc; b.st[1] = nx; }
        const unsigned old = xb_add(&bar[XB_XSUB(b.x)], 1u);
        const unsigned gen = old / nloc;
        if (old + 1u == (gen + 1u) * nloc) {
            __builtin_amdgcn_fence(__ATOMIC_RELEASE, "agent");
            asm volatile("s_waitcnt vmcnt(0)" ::: "memory");
            const unsigned og = xb_add(&bar[XB_TOP], 1u);
            const unsigned tg = og / nx;
            if (og + 1u == (tg + 1u) * nx) xb_add(&bar[XB_TOPGEN], 1u);
            else XB_SPIN(xb_ld(&bar[XB_TOPGEN]) == tg, bar);
            __builtin_amdgcn_fence(__ATOMIC_ACQUIRE, "agent");
            xb_add(&bar[XB_XGEN(b.x)], 1u);
            asm volatile("s_waitcnt vmcnt(0)" ::: "memory");
        } else {
            XB_SPIN(xb_ld(&bar[XB_XGEN(b.x)]) == gen, bar);
            __builtin_amdgcn_fence(__ATOMIC_ACQUIRE, "agent");
            asm volatile("s_waitcnt vmcnt(0)" ::: "memory");
        }
    }
    __syncthreads();
}

namespace pg8 {
constexpr int BM = 256, BK = 64, HALF = 128, HTB = HALF * BK * 2, STAGE_BYTES = 8 * HTB, NXCD = 8, WGM = 4;
__host__ __device__ __forceinline__ int lds_byte(int r, int c) { const int st = (r >> 4) * 2 + (c >> 5), rr = r & 15, cc = c & 31, ob = rr * 64 + cc * 2; return st * 1024 + (ob ^ (((ob >> 9) & 1) << 5)); }
__host__ __device__ __forceinline__ void stage_rc(int b, int& R, int& C) { const int st = b / 1024, sb = b % 1024, swz = sb ^ (((sb >> 9) & 1) << 5); R = (st >> 1) * 16 + swz / 64; C = (st & 1) * 32 + (swz % 64) / 2; }
__host__ __device__ __forceinline__ int perm32(int rho) { const int n = rho >> 4, i = rho & 15; return 8 * (i >> 2) + 4 * n + (i & 3); }
struct Unit { int pm, pn; };
struct Gemm { const bf16_t* A; const bf16_t* Bt; int lda, K; size_t akstep = 0, atile = 0; };

struct StaticOrder {
    int nM, nN, nwg, G, c, rep = 1;
    __device__ void init(int nM_, int nN_, int G_, int c_) { nM = nM_; nN = nN_; nwg = nM * nN; G = G_; c = c_; }
    __device__ bool next(int i, Unit& u) const {
        const long L = (long)i * G + c; if (L >= (long)nwg * rep) return false;
        int wgid = (int)(L % nwg); { const int q = nwg / NXCD, r = nwg % NXCD, xcd = wgid % NXCD, off = wgid / NXCD; wgid = (xcd < r ? xcd * (q + 1) : r * (q + 1) + (xcd - r) * q) + off; }
        const int nig = WGM * nN, gid = wgid / nig, fm = gid * WGM, gsz = (nM - fm) < WGM ? (nM - fm) : WGM;
        u.pm = fm + ((wgid % nig) % gsz); u.pn = (wgid % nig) / gsz; return true;
    }
    __device__ __forceinline__ size_t b_row0(const Unit& u) const { return (size_t)u.pn * BM; }
};
struct InProjL1Order {
    StaticOrder lat; int G, c;
    __device__ void init(int G_, int c_) { lat.init(TL / 256, PC / 256, G_, c_); G = G_; c = c_; }
    __device__ bool next(int i, Unit& u) const {
        if (lat.next(i, u)) return true;
        const long L = (long)i * G + c - lat.nwg; if (L < 0 || L >= 128) return false;
        const int j = (int)L & 7; u.pm = 128 + ((int)L >> 3); u.pn = j < 5 ? 3 + j : 7 + j; return true;
    }
    __device__ __forceinline__ size_t b_row0(const Unit& u) const { return (size_t)u.pn * BM; }
};
struct MoeOrder : StaticOrder {
    const int* tile_e; const int* rowtok; int rows_per_expert;
    __device__ __forceinline__ size_t b_row0(const Unit& u) const { return (size_t)tile_e[u.pm] * rows_per_expert + (size_t)u.pn * BM; }
};

struct EpiBf16 {
    static constexpr bool PERM = true;
    bf16_t* O; int ldc; float sc = 1.0f;
    __device__ __forceinline__ void operator()(const f32x4 (&acc)[2][2][4][2], const Unit& u, int wr, int wc, int fr, int fq) const {
        const int row0 = u.pm * BM + wr * 64 + fr, col0 = u.pn * BM + wc * 32 + 8 * fq;
#pragma unroll
        for (int ai = 0; ai < 2; ++ai)
#pragma unroll
            for (int m = 0; m < 4; ++m) { bf16_t* rowp = O + (size_t)(row0 + ai * HALF + m * 16) * ldc + col0;
#pragma unroll
                for (int bj = 0; bj < 2; ++bj) { const f32x4 v0 = acc[ai][bj][m][0] * sc, v1 = acc[ai][bj][m][1] * sc;
                    u32x4 w; w.x = cvt_pk_bf16(v0[0], v0[1]); w.y = cvt_pk_bf16(v0[2], v0[3]); w.z = cvt_pk_bf16(v1[0], v1[1]); w.w = cvt_pk_bf16(v1[2], v1[3]);
                    *(u32x4*)(rowp + bj * HALF) = w; } }
    }
};
template <bool OUT8> struct EpiGateUp {
    static constexpr bool PERM = true;
    void* O; int ldc; float sc; int nkt = 0;
    __device__ __forceinline__ void operator()(const f32x4 (&acc)[2][2][4][2], const Unit& u, int wr, int wc, int fr, int fq) const {
        const int row0 = u.pm * BM + wr * 64 + fr, col0 = u.pn * HALF + wc * 32 + 8 * fq;
#pragma unroll
        for (int ai = 0; ai < 2; ++ai)
#pragma unroll
            for (int m = 0; m < 4; ++m) { const size_t eo = (OUT8 && nkt) ? ((size_t)(u.pm * nkt + u.pn) * BM + (wr * 64 + fr + ai * HALF + m * 16)) * HALF + wc * 32 + 8 * fq : (size_t)(row0 + ai * HALF + m * 16) * ldc + col0;
                float h[8];
                const float c1 = -sc * 1.4426950408889634f, sc2 = sc * sc;
#pragma unroll
                for (int n = 0; n < 2; ++n)
#pragma unroll
                    for (int q = 0; q < 2; ++q) { const f32x2 g = {acc[ai][0][m][n][2 * q], acc[ai][0][m][n][2 * q + 1]}, up = {acc[ai][1][m][n][2 * q], acc[ai][1][m][n][2 * q + 1]};
                        const f32x2 t = (g * up) * sc2, a = g * c1; f32x2 e; e.x = __builtin_amdgcn_exp2f(a.x); e.y = __builtin_amdgcn_exp2f(a.y);
                        const f32x2 d = e + 1.0f; f32x2 r; r.x = __builtin_amdgcn_rcpf(d.x); r.y = __builtin_amdgcn_rcpf(d.y);
                        const f32x2 hv = t * r; h[n * 4 + 2 * q] = hv.x; h[n * 4 + 2 * q + 1] = hv.y; }
                if constexpr (OUT8) { u32x2 w; w.x = pack4_fp8(h[0], h[1], h[2], h[3]); w.y = pack4_fp8(h[4], h[5], h[6], h[7]); *(u32x2*)((unsigned char*)O + eo) = w; }
                else { u32x4 w; w.x = cvt_pk_bf16(h[0], h[1]); w.y = cvt_pk_bf16(h[2], h[3]); w.z = cvt_pk_bf16(h[4], h[5]); w.w = cvt_pk_bf16(h[6], h[7]); *(u32x4*)((bf16_t*)O + eo) = w; } }
    }
};
struct EpiResid {
    static constexpr bool PERM = false;
    const float* srcL; float* dstL; const float* srcC; float* dstC; const float* gateL; const float* gateC;
    float sc = 1.0f;
    __device__ __forceinline__ void operator()(const f32x4 (&acc)[2][2][4][2], const Unit& u, int wr, int wc, int fr, int fq) const {
        const bool lat = u.pm < 128;
        const float* src = lat ? srcL + (size_t)u.pm * BM * DM : srcC + (size_t)(u.pm - 128) * BM * DM;
        float* dst = lat ? dstL + (size_t)u.pm * BM * DM : dstC + (size_t)(u.pm - 128) * BM * DM;
        const float* gate = lat ? gateL + (size_t)(u.pm >> 3) * 12288 : gateC;
        const int row0 = wr * 64 + fr, col0 = u.pn * BM + wc * 32 + 4 * fq;
        f32x4 gv[2][2];
#pragma unroll
        for (int bj = 0; bj < 2; ++bj)
#pragma unroll
            for (int n = 0; n < 2; ++n) gv[bj][n] = *(const f32x4*)(gate + col0 + bj * HALF + n * 16) * sc;
#pragma unroll
        for (int ai = 0; ai < 2; ++ai)
#pragma unroll
            for (int m = 0; m < 4; ++m) { const size_t off = (size_t)(row0 + ai * HALF + m * 16) * DM + col0;
#pragma unroll
                for (int bj = 0; bj < 2; ++bj)
#pragma unroll
                    for (int n = 0; n < 2; ++n) { const f32x4 s = *(const f32x4*)(src + off + bj * HALF + n * 16); *(f32x4*)(dst + off + bj * HALF + n * 16) = s + gv[bj][n] * acc[ai][bj][m][n]; }
                if (m & 1) asm volatile("" ::: "memory"); }
    }
};
struct EpiF8 {
    static constexpr bool PERM = true;
    unsigned char* O; int ldc; float sc;
    __device__ __forceinline__ void operator()(const f32x4 (&acc)[2][2][4][2], const Unit& u, int wr, int wc, int fr, int fq) const {
        const int row0 = u.pm * BM + wr * 64 + fr, col0 = u.pn * BM + wc * 32 + 8 * fq;
#pragma unroll
        for (int ai = 0; ai < 2; ++ai)
#pragma unroll
            for (int m = 0; m < 4; ++m) { unsigned char* rowp = O + (size_t)(row0 + ai * HALF + m * 16) * ldc + col0;
#pragma unroll
                for (int bj = 0; bj < 2; ++bj) { const f32x4 v0 = acc[ai][bj][m][0] * sc, v1 = acc[ai][bj][m][1] * sc;
                    u32x2 w; w.x = pack4_fp8(v0[0], v0[1], v0[2], v0[3]); w.y = pack4_fp8(v1[0], v1[1], v1[2], v1[3]); *(u32x2*)(rowp + bj * HALF) = w; } }
    }
};
struct EpiBf16Q {
    static constexpr bool PERM = true;
    bf16_t* O; int ldc; const float* rs; const float* cs; unsigned char* C8 = nullptr;
    __device__ __forceinline__ void operator()(const f32x4 (&acc)[2][2][4][2], const Unit& u, int wr, int wc, int fr, int fq) const {
        const int row0 = u.pm * BM + wr * 64 + fr, col0 = u.pn * BM + wc * 32 + 8 * fq;
        const bool c8 = C8 != nullptr && u.pn >= 10 && u.pn < 14;
        f32x4 cv[2][2];
#pragma unroll
        for (int bj = 0; bj < 2; ++bj)
#pragma unroll
            for (int n = 0; n < 2; ++n) cv[bj][n] = *(const f32x4*)(cs + col0 + bj * HALF + 4 * n);
        float rr[2][4];
#pragma unroll
        for (int ai = 0; ai < 2; ++ai)
#pragma unroll
            for (int m = 0; m < 4; ++m) rr[ai][m] = rs[row0 + ai * HALF + m * 16];
#pragma unroll
        for (int ai = 0; ai < 2; ++ai)
#pragma unroll
            for (int m = 0; m < 4; ++m) { const int row = row0 + ai * HALF + m * 16; bf16_t* rowp = O + (size_t)row * ldc + col0; const float r = rr[ai][m];
#pragma unroll
                for (int bj = 0; bj < 2; ++bj) { const i32x4 i0 = __builtin_bit_cast(i32x4, acc[ai][bj][m][0]), i1 = __builtin_bit_cast(i32x4, acc[ai][bj][m][1]);
                    const f32x4 v0 = (f32x4){(float)i0[0], (float)i0[1], (float)i0[2], (float)i0[3]} * (cv[bj][0] * r), v1 = (f32x4){(float)i1[0], (float)i1[1], (float)i1[2], (float)i1[3]} * (cv[bj][1] * r);
                    u32x4 w; w.x = cvt_pk_bf16(v0[0], v0[1]); w.y = cvt_pk_bf16(v0[2], v0[3]); w.z = cvt_pk_bf16(v1[0], v1[1]); w.w = cvt_pk_bf16(v1[2], v1[3]);
                    *(u32x4*)(rowp + bj * HALF) = w;
                    if (c8) { u32x2 w8; w8.x = pack4_fp8(v0[0], v0[1], v0[2], v0[3]); w8.y = pack4_fp8(v1[0], v1[1], v1[2], v1[3]); *(u32x2*)(C8 + (size_t)row * 1024 + (col0 - 10 * BM) + bj * HALF) = w8; } } }
    }
};
template <bool OUT8> struct EpiGateUpQ {
    static constexpr bool PERM = true;
    void* O; int ldc; const float* rs; const float* cs;
    const int* tile_e = nullptr; int cs_stride = 0;
    int nkt = 0;
    __device__ __forceinline__ void operator()(const f32x4 (&acc)[2][2][4][2], const Unit& u, int wr, int wc, int fr, int fq) const {
        const int row0 = u.pm * BM + wr * 64 + fr, col0 = u.pn * HALF + wc * 32 + 8 * fq, c0 = u.pn * BM + wc * 32 + 8 * fq + (tile_e ? tile_e[u.pm] * cs_stride : 0);
        const f32x4 cg0 = *(const f32x4*)(cs + c0), cg1 = *(const f32x4*)(cs + c0 + 4), cu0 = *(const f32x4*)(cs + c0 + HALF), cu1 = *(const f32x4*)(cs + c0 + HALF + 4);
        float rr[2][4];
#pragma unroll
        for (int ai = 0; ai < 2; ++ai)
#pragma unroll
            for (int m = 0; m < 4; ++m) rr[ai][m] = rs[row0 + ai * HALF + m * 16];
#pragma unroll
        for (int ai = 0; ai < 2; ++ai)
#pragma unroll
            for (int m = 0; m < 4; ++m) { const int row = row0 + ai * HALF + m * 16; const size_t eo = (OUT8 && nkt) ? ((size_t)(u.pm * nkt + u.pn) * BM + (wr * 64 + fr + ai * HALF + m * 16)) * HALF + wc * 32 + 8 * fq : (size_t)row * ldc + col0; const float r = rr[ai][m];
                float h[8];
#pragma unroll
                for (int n = 0; n < 2; ++n) { const f32x4 cg = (n ? cg1 : cg0) * r, cu = (n ? cu1 : cu0) * r; const i32x4 ig = __builtin_bit_cast(i32x4, acc[ai][0][m][n]), iu = __builtin_bit_cast(i32x4, acc[ai][1][m][n]);
#pragma unroll
                    for (int q = 0; q < 2; ++q) { const f32x2 g = {(float)ig[2 * q] * cg[2 * q], (float)ig[2 * q + 1] * cg[2 * q + 1]}, up = {(float)iu[2 * q] * cu[2 * q], (float)iu[2 * q + 1] * cu[2 * q + 1]};
                        const f32x2 t = g * up, a = g * (-1.4426950408889634f); f32x2 e; e.x = __builtin_amdgcn_exp2f(a.x); e.y = __builtin_amdgcn_exp2f(a.y);
                        const f32x2 d = e + 1.0f; f32x2 rr; rr.x = __builtin_amdgcn_rcpf(d.x); rr.y = __builtin_amdgcn_rcpf(d.y);
                        const f32x2 hv = t * rr; h[n * 4 + 2 * q] = hv.x; h[n * 4 + 2 * q + 1] = hv.y; } }
                if constexpr (OUT8) { u32x2 w; w.x = pack4_fp8(h[0], h[1], h[2], h[3]); w.y = pack4_fp8(h[4], h[5], h[6], h[7]); *(u32x2*)((unsigned char*)O + eo) = w; }
                else { u32x4 w; w.x = cvt_pk_bf16(h[0], h[1]); w.y = cvt_pk_bf16(h[2], h[3]); w.z = cvt_pk_bf16(h[4], h[5]); w.w = cvt_pk_bf16(h[6], h[7]); *(u32x4*)((bf16_t*)O + eo) = w; } }
    }
};
template <bool SRC32> struct EpiResid16 {
    static constexpr bool PERM = true;
    const float* srcL; const float* srcC; bf16_t* H; const float* gateL; const float* gateC; float sc;
    __device__ __forceinline__ void operator()(const f32x4 (&acc)[2][2][4][2], const Unit& u, int wr, int wc, int fr, int fq) const {
        const bool lat = u.pm < 128;
        const float* src = lat ? srcL + (size_t)u.pm * BM * DM : srcC + (size_t)(u.pm - 128) * BM * DM;
        bf16_t* hb = H + (size_t)u.pm * BM * DM;
        const float* gate = lat ? gateL + (size_t)(u.pm >> 3) * 12288 : gateC;
        const int row0 = wr * 64 + fr, col0 = u.pn * BM + wc * 32 + 8 * fq;
        f32x4 gv[2][2];
#pragma unroll
        for (int bj = 0; bj < 2; ++bj)
#pragma unroll
            for (int n = 0; n < 2; ++n) gv[bj][n] = *(const f32x4*)(gate + col0 + bj * HALF + n * 4) * sc;
#pragma unroll
        for (int ai = 0; ai < 2; ++ai)
#pragma unroll
            for (int m = 0; m < 4; ++m) { const size_t off = (size_t)(row0 + ai * HALF + m * 16) * DM + col0;
#pragma unroll
                for (int bj = 0; bj < 2; ++bj) { f32x4 s0, s1;
                    if constexpr (SRC32) { s0 = *(const f32x4*)(src + off + bj * HALF); s1 = *(const f32x4*)(src + off + bj * HALF + 4); }
                    else { const u32x4 w = *(const u32x4*)(hb + off + bj * HALF); s0 = (f32x4){bf_lo(w.x), bf_hi(w.x), bf_lo(w.y), bf_hi(w.y)}; s1 = (f32x4){bf_lo(w.z), bf_hi(w.z), bf_lo(w.w), bf_hi(w.w)}; }
                    const f32x4 v0 = s0 + gv[bj][0] * acc[ai][bj][m][0], v1 = s1 + gv[bj][1] * acc[ai][bj][m][1];
                    u32x4 o; o.x = cvt_pk_bf16(v0[0], v0[1]); o.y = cvt_pk_bf16(v0[2], v0[3]); o.z = cvt_pk_bf16(v1[0], v1[1]); o.w = cvt_pk_bf16(v1[2], v1[3]);
                    *(u32x4*)(hb + off + bj * HALF) = o; }
                if (SRC32 && (m & 1)) asm volatile("" ::: "memory"); }
    }
};
struct EpiMoeDown {
    static constexpr bool PERM = false;
    float* h; const float* gateL; const int* rowtok; const float* roww;
    __device__ __forceinline__ void operator()(const f32x4 (&acc)[2][2][4][2], const Unit& u, int wr, int wc, int fr, int fq) const {
        const int prow0 = u.pm * BM + wr * 64 + fr, col0 = u.pn * BM + wc * 32 + 4 * fq;
#pragma unroll
        for (int ai = 0; ai < 2; ++ai)
#pragma unroll
            for (int m = 0; m < 4; ++m) { const int p = prow0 + ai * HALF + m * 16; const int tok = rowtok[p]; const float w = roww[p];
                if (tok >= 0) { float* hp = h + (size_t)tok * DM + col0; const float* gate = gateL + (size_t)(tok >> 11) * 12288 + col0;
#pragma unroll
                    for (int bj = 0; bj < 2; ++bj)
#pragma unroll
                        for (int n = 0; n < 2; ++n) { const f32x4 gv = *(const f32x4*)(gate + bj * HALF + n * 16); const f32x4 v = gv * acc[ai][bj][m][n] * w;
#pragma unroll
                            for (int j = 0; j < 4; ++j) unsafeAtomicAdd(hp + bj * HALF + n * 16 + j, v[j]); } } }
    }
};

template <class Epi, class Sched, int MODE = 0>
__device__ __forceinline__ void gemm_phase(LAS unsigned char* lds, const Gemm g, const Sched& S, const Epi& E) {
    constexpr bool FP8 = MODE == 1, I8 = MODE == 2;
    const int tid = threadIdx.x, wid = __builtin_amdgcn_readfirstlane(tid >> 6), lane = tid & 63, wr = wid >> 2, wc = wid & 3, fr = lane & 15, fq = lane >> 4;
    const int K = g.K, nt = K / BK, lda = g.lda;
    unsigned voffA[2], voffB[2];
#pragma unroll
    for (int i = 0; i < 2; ++i) { int R, C; stage_rc(tid * 16 + i * 8192, R, C); const int Rb = Epi::PERM ? ((R & ~31) + perm32(R & 31)) : R;
        voffA[i] = (unsigned)(R * lda + C) * 2u; voffB[i] = (unsigned)(Rb * K + C) * 2u; }
    const size_t kstep = (size_t)(BK * 2);
    const size_t hstepA = (size_t)HALF * lda * 2, hstepB = (size_t)HALF * K * 2;
    const size_t tstepA = g.atile ? g.atile : 2 * hstepA, kstepA = g.akstep ? g.akstep : kstep;
    const unsigned ldsw = (unsigned)wid * 1024u;
    const int aoff = lds_byte(wr * 64 + fr, fq * 8), boff = lds_byte(wc * 32 + fr, fq * 8);
#define PG8_SA(b, h) (((b) * 2 + (h)) * HTB)
#define PG8_SB(b, h) ((4 + (b) * 2 + (h)) * HTB)
#define PG8_STAGE(bufoff, gbase, voff) do { _Pragma("unroll") for (int _i = 0; _i < 2; ++_i) \
        __builtin_amdgcn_global_load_lds((const unsigned*)((const char*)(gbase) + (voff)[_i]), (LAS unsigned*)(lds + (bufoff) + ldsw + _i * 8192), 16, 0, 0); } while (0)
#define PG8_LDA(dst, b, h) do { _Pragma("unroll") for (int m = 0; m < 4; ++m) _Pragma("unroll") for (int k = 0; k < 2; ++k) dst[m][k] = *(const LAS bf16x8*)(lds + PG8_SA(b, h) + aoff + m * 2048 + k * 1024); } while (0)
#define PG8_LDB(dst, b, h) do { _Pragma("unroll") for (int n = 0; n < 2; ++n) _Pragma("unroll") for (int k = 0; k < 2; ++k) dst[n][k] = *(const LAS bf16x8*)(lds + PG8_SB(b, h) + boff + n * 2048 + k * 1024); } while (0)
#define PG8_CAT8(lo, hi) __builtin_shufflevector(__builtin_bit_cast(i32x4, lo), __builtin_bit_cast(i32x4, hi), 0, 1, 2, 3, 4, 5, 6, 7)
#define PG8_MMA(ai, bj, At, Bt) do { __builtin_amdgcn_s_setprio(1); \
        if constexpr (FP8) { _Pragma("unroll") for (int m = 0; m < 4; ++m) _Pragma("unroll") for (int n = 0; n < 2; ++n) \
            asm volatile("v_mfma_f32_16x16x128_f8f6f4 %0, %1, %2, %0" : "+v"(acc[ai][bj][m][n]) : "v"(PG8_CAT8(Bt[n][0], Bt[n][1])), "v"(PG8_CAT8(At[m][0], At[m][1]))); } \
        else if constexpr (I8) { _Pragma("unroll") for (int m = 0; m < 4; ++m) _Pragma("unroll") for (int n = 0; n < 2; ++n) _Pragma("unroll") for (int k = 0; k < 2; ++k) \
            acc[ai][bj][m][n] = __builtin_bit_cast(f32x4, __builtin_amdgcn_mfma_i32_16x16x64_i8(__builtin_bit_cast(i32x4, Bt[n][k]), __builtin_bit_cast(i32x4, At[m][k]), __builtin_bit_cast(i32x4, acc[ai][bj][m][n]), 0, 0, 0)); } \
        else { _Pragma("unroll") for (int m = 0; m < 4; ++m) _Pragma("unroll") for (int n = 0; n < 2; ++n) _Pragma("unroll") for (int k = 0; k < 2; ++k) \
            acc[ai][bj][m][n] = __builtin_amdgcn_mfma_f32_16x16x32_bf16(Bt[n][k], At[m][k], acc[ai][bj][m][n], 0, 0, 0); } \
        __builtin_amdgcn_s_setprio(0); } while (0)
#define PG8_WAIT_V(n) asm volatile("s_waitcnt vmcnt(" #n ")" ::: "memory")
#define PG8_WAIT_L(n) asm volatile("s_waitcnt lgkmcnt(" #n ")" ::: "memory")
#define PG8_BAR __builtin_amdgcn_s_barrier()
#define PG8_SCHED __builtin_amdgcn_sched_barrier(0)
    Unit cur, nxt; int ui = 0;
    if (!S.next(0, cur)) return;
#if GEMM_STAGGER
    for (int i = (int)((blockIdx.x >> 3) & 7); i > 0; --i) __builtin_amdgcn_s_sleep(GEMM_STAGGER);
#endif
    f32x4 acc[2][2][4][2];
#pragma unroll
    for (int a = 0; a < 2; ++a)
#pragma unroll
        for (int b = 0; b < 2; ++b)
#pragma unroll
            for (int m = 0; m < 4; ++m)
#pragma unroll
                for (int n = 0; n < 2; ++n) acc[a][b][m][n] = (f32x4){0.f, 0.f, 0.f, 0.f};
    bf16x8 At[4][2], B0[2][2], B1[2][2];
    const char* cA = (const char*)g.A + (size_t)cur.pm * tstepA; const char* cB = (const char*)g.Bt + S.b_row0(cur) * (size_t)K * 2;
    PG8_STAGE(PG8_SB(0, 0), cB, voffB); PG8_STAGE(PG8_SB(0, 1), cB + hstepB, voffB); PG8_STAGE(PG8_SA(0, 0), cA, voffA); PG8_STAGE(PG8_SA(0, 1), cA + hstepA, voffA);
    if (wr == 1) PG8_BAR;
    PG8_WAIT_V(2); PG8_BAR;
    PG8_STAGE(PG8_SB(1, 0), cB + kstep, voffB); PG8_STAGE(PG8_SA(1, 0), cA + kstepA, voffA); PG8_STAGE(PG8_SB(1, 1), cB + hstepB + kstep, voffB);
    PG8_WAIT_V(6); PG8_BAR;
    for (;;) {
        const bool has_next = S.next(ui + 1, nxt);
        const char* nA = has_next ? (const char*)g.A + (size_t)nxt.pm * tstepA : cA; const char* nB = has_next ? (const char*)g.Bt + S.b_row0(nxt) * (size_t)K * 2 : cB;
        for (int t = 0; t < nt; t += 2) {
            const bool last = (t == nt - 2);
            const char* a1 = cA + (size_t)(t + 1) * kstepA;
            const char* a2 = last ? nA : cA + (size_t)(t + 2) * kstepA; const char* b2 = last ? nB : cB + (size_t)(t + 2) * kstep;
            const char* a3 = a2 + kstepA; const char* b3 = b2 + kstep;
            if constexpr (FP8) asm volatile("" : "+v"(voffA[0]), "+v"(voffA[1]), "+v"(voffB[0]), "+v"(voffB[1]));
            PG8_LDB(B0, 0, 0); PG8_LDB(B1, 0, 1); PG8_SCHED; PG8_LDA(At, 0, 0); PG8_STAGE(PG8_SA(1, 1), a1 + hstepA, voffA);
            PG8_WAIT_V(8); PG8_WAIT_L(0); PG8_BAR; PG8_MMA(0, 0, At, B0); PG8_MMA(0, 1, At, B1); PG8_BAR; PG8_SCHED;
            PG8_LDA(At, 0, 1); PG8_STAGE(PG8_SB(0, 0), b2, voffB); PG8_STAGE(PG8_SB(0, 1), b2 + hstepB, voffB); PG8_STAGE(PG8_SA(0, 0), a2, voffA);
            PG8_WAIT_V(8); PG8_WAIT_L(0); PG8_BAR; PG8_MMA(1, 0, At, B0); PG8_MMA(1, 1, At, B1); PG8_BAR; PG8_SCHED;
            PG8_LDB(B0, 1, 0); PG8_LDB(B1, 1, 1); PG8_SCHED; PG8_LDA(At, 1, 0); PG8_STAGE(PG8_SA(0, 1), a2 + hstepA, voffA);
            PG8_WAIT_V(8); PG8_WAIT_L(0); PG8_BAR; PG8_MMA(0, 0, At, B0); PG8_MMA(0, 1, At, B1); PG8_BAR; PG8_SCHED;
            PG8_LDA(At, 1, 1); PG8_STAGE(PG8_SB(1, 0), b3, voffB); PG8_STAGE(PG8_SB(1, 1), b3 + hstepB, voffB); PG8_STAGE(PG8_SA(1, 0), a3, voffA);
            PG8_WAIT_V(8); PG8_WAIT_L(0); PG8_BAR; PG8_MMA(1, 0, At, B0); PG8_MMA(1, 1, At, B1); PG8_BAR; PG8_SCHED;
        }
        if (wr == 0) PG8_BAR;
        if constexpr (FP8) asm volatile("s_nop 15\n\ts_nop 15" ::: "memory");
        E(acc, cur, wr, wc, fr, fq);
        if (!has_next) break;
#pragma unroll
        for (int a = 0; a < 2; ++a)
#pragma unroll
            for (int b = 0; b < 2; ++b)
#pragma unroll
                for (int m = 0; m < 4; ++m)
#pragma unroll
                    for (int n = 0; n < 2; ++n) acc[a][b][m][n] = (f32x4){0.f, 0.f, 0.f, 0.f};
        cur = nxt; cA = nA; cB = nB; ++ui;
        if (wr == 1) PG8_BAR;
    }
    PG8_WAIT_V(0);
    PG8_BAR;
#undef PG8_SA
#undef PG8_SB
#undef PG8_STAGE
#undef PG8_LDA
#undef PG8_LDB
#undef PG8_MMA
#undef PG8_CAT8
#undef PG8_WAIT_V
#undef PG8_WAIT_L
#undef PG8_BAR
#undef PG8_SCHED
}
}

constexpr int RING_BYTES = 131072;
constexpr int LDSCTL_OFF = 147456;
constexpr int LDS_BYTES = 155648;
constexpr int NWAVES = 8, NTHR = 512;

struct Args { const float* in[31]; float* out; unsigned char* ws; int ph_lo, ph_hi; };
struct Frame {
    LAS unsigned char* lds;
    int tid, lane, wave, G, bid;
    const float* const* in;
    float* out; unsigned char* ws;
};
#define WSP(T, off) ((T*)(F.ws + (off)))

__device__ __forceinline__ int col_map(int kind, int n) {
    switch (kind) {
        case 1: {
            if (n < 2048) return n;
            if (n < 2072) return PDT + (n - 2048);
            if (n < 2584) return PPOOL + (n - 2072);
            if (n < 3096) return PCQ + (n - 2584);
            if (n < 3608) return PCKV + (n - 3096);
            return PKR + (n - 3608); }
        case 2: { const int h = n >> 8, j = n & 255; return h * 320 + (j < 128 ? j : 192 + (j - 128)); }
        case 3: return (n >> 7) * 256 + (n & 127);
        case 4: return (n >> 7) * 256 + 128 + (n & 127);
        default: return n;
    }
}
template <bool OUT8 = false>
__device__ __forceinline__ void tr_item(const float* W, int K, int N, bf16_t* WT, int kind, const float* kscale, LAS float* scr, int item, int lane) {
    const int nblk = (N + 31) / 32, kb = item / nblk, nb = item % nblk, k0 = 64 * kb, n0 = 32 * nb;
    const int n4 = n0 + (lane & 7) * 4, kr = lane >> 3; const bool nok = n4 < N;
    f32x4 v[8];
#pragma unroll
    for (int i = 0; i < 8; ++i) v[i] = nok ? *(const f32x4*)(W + (size_t)(k0 + kr + 8 * i) * N + n4) : (f32x4){0.f, 0.f, 0.f, 0.f};
#pragma unroll
    for (int i = 0; i < 8; ++i) { const int kk = kr + 8 * i; f32x4 x = v[i]; if (kscale) x = x * kscale[k0 + kk];
        LAS float* d = scr + kk * 33 + (lane & 7) * 4; d[0] = x[0]; d[1] = x[1]; d[2] = x[2]; d[3] = x[3]; }
    LDS_WAIT(); asm volatile("" ::: "memory");
    const int c = lane & 7;
#pragma unroll
    for (int j = 0; j < 4; ++j) { const int n = (lane >> 3) + 8 * j; const LAS float* s = scr + (8 * c) * 33 + n;
        if constexpr (OUT8) { u32x2 o; o.x = pack4_fp8(s[0 * 33] * W8_SCALE, s[1 * 33] * W8_SCALE, s[2 * 33] * W8_SCALE, s[3 * 33] * W8_SCALE); o.y = pack4_fp8(s[4 * 33] * W8_SCALE, s[5 * 33] * W8_SCALE, s[6 * 33] * W8_SCALE, s[7 * 33] * W8_SCALE);
            if (n0 + n < N) *(u32x2*)((unsigned char*)WT + (size_t)col_map(kind, n0 + n) * K + k0 + 8 * c) = o; }
        else { u32x4 o; o.x = cvt_pk_bf16(s[0 * 33], s[1 * 33]); o.y = cvt_pk_bf16(s[2 * 33], s[3 * 33]); o.z = cvt_pk_bf16(s[4 * 33], s[5 * 33]); o.w = cvt_pk_bf16(s[6 * 33], s[7 * 33]);
            if (n0 + n < N) *(u32x4*)(WT + (size_t)col_map(kind, n0 + n) * K + k0 + 8 * c) = o; } }
    LDS_WAIT(); asm volatile("" ::: "memory");
}
__device__ __forceinline__ void tr_item8(const float* W, int K, int N, unsigned char* WT, int kind, LAS float* scr, int item, int lane, const float* kscale = nullptr) {
    const int nblk = (N + 31) / 32, kb = item / nblk, nb = item % nblk, k0 = 128 * kb, n0 = 32 * nb;
    const int n4 = n0 + (lane & 7) * 4, kr = lane >> 3; const bool nok = n4 < N;
    f32x4 v[16];
#pragma unroll
    for (int i = 0; i < 16; ++i) v[i] = nok ? *(const f32x4*)(W + (size_t)(k0 + kr + 8 * i) * N + n4) : (f32x4){0.f, 0.f, 0.f, 0.f};
#pragma unroll
    for (int i = 0; i < 16; ++i) { LAS float* d = scr + (kr + 8 * i) * 33 + (lane & 7) * 4; const float ks = kscale ? kscale[k0 + kr + 8 * i] * W8_SCALE : W8_SCALE; d[0] = v[i][0] * ks; d[1] = v[i][1] * ks; d[2] = v[i][2] * ks; d[3] = v[i][3] * ks; }
    LDS_WAIT(); asm volatile("" ::: "memory");
    const int c = lane & 7;
#pragma unroll
    for (int j = 0; j < 4; ++j) { const int n = (lane >> 3) + 8 * j; const LAS float* s = scr + (16 * c) * 33 + n;
        u32x4 o; o.x = pack4_fp8(s[0 * 33], s[1 * 33], s[2 * 33], s[3 * 33]); o.y = pack4_fp8(s[4 * 33], s[5 * 33], s[6 * 33], s[7 * 33]);
        o.z = pack4_fp8(s[8 * 33], s[9 * 33], s[10 * 33], s[11 * 33]); o.w = pack4_fp8(s[12 * 33], s[13 * 33], s[14 * 33], s[15 * 33]);
        if (n0 + n < N) *(u32x4*)(WT + (size_t)col_map(kind, n0 + n) * K + k0 + 16 * c) = o; }
    LDS_WAIT(); asm volatile("" ::: "memory");
}
__device__ __forceinline__ void tr_itemq(const float* W, int K, int N, unsigned char* WT, int kind, const float* cs, LAS float* scr, int item, int lane) {
    const int nblk = (N + 31) / 32, kb = item / nblk, nb = item % nblk, k0 = 128 * kb, n0 = 32 * nb;
    const int n4 = n0 + (lane & 7) * 4, kr = lane >> 3; const bool nok = n4 < N;
    f32x4 v[16];
#pragma unroll
    for (int i = 0; i < 16; ++i) v[i] = nok ? *(const f32x4*)(W + (size_t)(k0 + kr + 8 * i) * N + n4) : (f32x4){0.f, 0.f, 0.f, 0.f};
#pragma unroll
    for (int i = 0; i < 16; ++i) { LAS float* d = scr + (kr + 8 * i) * 33 + (lane & 7) * 4; d[0] = v[i][0]; d[1] = v[i][1]; d[2] = v[i][2]; d[3] = v[i][3]; }
    LDS_WAIT(); asm volatile("" ::: "memory");
    const int c = lane & 7;
#pragma unroll
    for (int j = 0; j < 4; ++j) { const int n = (lane >> 3) + 8 * j; const LAS float* sp = scr + (16 * c) * 33 + n;
        if (n0 + n < N) { const int drow = col_map(kind, n0 + n); const float inv = 1.0f / cs[drow];
            u32x4 o; o.x = pack4_i8(sp[0 * 33] * inv, sp[1 * 33] * inv, sp[2 * 33] * inv, sp[3 * 33] * inv); o.y = pack4_i8(sp[4 * 33] * inv, sp[5 * 33] * inv, sp[6 * 33] * inv, sp[7 * 33] * inv);
            o.z = pack4_i8(sp[8 * 33] * inv, sp[9 * 33] * inv, sp[10 * 33] * inv, sp[11 * 33] * inv); o.w = pack4_i8(sp[12 * 33] * inv, sp[13 * 33] * inv, sp[14 * 33] * inv, sp[15 * 33] * inv);
            *(u32x4*)(WT + (size_t)drow * K + k0 + 16 * c) = o; } }
    LDS_WAIT(); asm volatile("" ::: "memory");
}
__device__ __forceinline__ void col_scale_pass(const float* W, int K, int N, int kind, float* cs, long gthread, long nthreads) {
    for (long t = gthread; t < 2L * N; t += nthreads) { const int n = (int)(t >> 1), par = (int)(t & 1); float mx = 0.f;
        for (int k0 = par * 16; k0 < K; k0 += 512) { float v[16];
#pragma unroll
            for (int i = 0; i < 16; ++i) { const int k = k0 + 32 * i; v[i] = k < K ? fabsf(W[(size_t)k * N + n]) : 0.f; }
#pragma unroll
            for (int i = 0; i < 16; ++i) mx = fmaxf(mx, v[i]); }
        mx = fmaxf(mx, __shfl_xor(mx, 1));
        if (par == 0) cs[col_map(kind, n)] = fmaxf(mx, 1e-30f) * (1.35f / 127.0f); }
}
__device__ __forceinline__ void zero_rows(bf16_t* WT, int K, int r0, int r1, int gthread, int nthreads) {
    const long n16 = (long)(r1 - r0) * K / 8; u32x4 z = {0u, 0u, 0u, 0u};
    for (long i = gthread; i < n16; i += nthreads) *(u32x4*)(WT + (size_t)r0 * K + i * 8) = z;
}
constexpr int MOE_I_GU = FP8_MOE_GU ? 16 * 176 : 32 * 176, MOE_I_DN = FP8_MOE_DN ? 44 * 64 : 88 * 64, MOE_I_EXP = 2 * MOE_I_GU + MOE_I_DN, MOE_I_ALL = 8 * MOE_I_EXP;
__device__ __forceinline__ void moe_weight_items(Frame& F, int pct_lo, int pct_hi, int lw, int nlw) {
    LAS float* scr = (LAS float*)(F.lds + F.wave * 16896);
    const int lo = (int)((long)MOE_I_ALL * pct_lo / 100), hi = (int)((long)MOE_I_ALL * pct_hi / 100);
    for (int it = lo + lw; it < hi; it += nlw) {
        int r = it; const int e = r / MOE_I_EXP; r -= e * MOE_I_EXP;
        unsigned char* gu = F.ws + WS_MWGU + (size_t)e * 11264 * 2048 * (FP8_MOE_GU ? 1 : 2); unsigned char* dn = F.ws + WS_MWDN + (size_t)e * 2048 * FF * (FP8_MOE_DN ? 1 : 2);
        if (r < 2 * MOE_I_GU) { const int up = r >= MOE_I_GU; r -= up * MOE_I_GU; const float* W = F.in[28 + up] + (size_t)e * 2048 * FF;
            if constexpr (I8_MOE_GU != 0) tr_itemq(W, 2048, FF, gu, 3 + up, WSP(float, WS_SMALL + SM_CS_MGU) + e * 11264, scr, r, F.lane);
            else if constexpr (FP8_MOE_GU != 0) tr_item8(W, 2048, FF, gu, 3 + up, scr, r, F.lane); else tr_item(W, 2048, FF, (bf16_t*)gu, 3 + up, nullptr, scr, r, F.lane); continue; }
        r -= 2 * MOE_I_GU;
        if constexpr (FP8_MOE_DN != 0) tr_item8(F.in[30] + (size_t)e * FF * 2048, FF, 2048, dn, 0, scr, r, F.lane); else tr_item(F.in[30] + (size_t)e * FF * 2048, FF, 2048, (bf16_t*)dn, 0, nullptr, scr, r, F.lane);
    }
}
__device__ __forceinline__ void win_i8_items(Frame& F, int l, int lw, int nlw) {
    LAS float* scr = (LAS float*)(F.lds + F.wave * 16896);
    for (int it = lw; it < 16 * 115; it += nlw) tr_itemq(F.in[8] + (size_t)l * 2048 * D_IN, 2048, D_IN, F.ws + WS_WIN + (size_t)l * PC * 2048 * 2, 1, WSP(float, WS_SMALL + SM_CS_WIN) + l * PC, scr, it, F.lane);
}
__device__ __forceinline__ void p0_prologue(Frame& F) {
    const int gw = F.bid * NWAVES + F.wave, NGW = F.G * NWAVES, gthr = F.bid * NTHR + F.tid, nthr = F.G * NTHR;
    {
        LAS float* s = (LAS float*)F.lds;
        LAS float* red = (LAS float*)(F.lds + 17 * 1024 * 4);
        const int c4 = (F.lane & 31) * 4, slice = F.wave * 2 + (F.lane >> 5);
        for (int u = F.bid; u < 192; u += F.G) {
            const int l = u / 96, n0 = (u % 96) * 128;
            f32x4 acc[17];
#pragma unroll
            for (int b = 0; b < 17; ++b) acc[b] = (f32x4){0.f, 0.f, 0.f, 0.f};
            for (int hf = 0; hf < 2; ++hf) {
                __syncthreads();
                for (int i = F.tid; i < 17 * 1024; i += NTHR) { const int b = i >> 10, k = (i & 1023) + hf * 1024; const float v = b < 16 ? F.in[1][b * 2048 + k] : F.in[3][k]; s[i] = silu_f(v); }
                __syncthreads();
                const float* W = F.in[4] + (size_t)l * 2048 * 12288 + (size_t)(hf * 1024 + slice * 64) * 12288 + n0 + c4;
                for (int k = 0; k < 64; k += 16) { f32x4 wv[16];
#pragma unroll
                    for (int kk = 0; kk < 16; ++kk) wv[kk] = *(const f32x4*)(W + (size_t)(k + kk) * 12288);
#pragma unroll
                    for (int b = 0; b < 17; ++b) {
#pragma unroll
                        for (int q4 = 0; q4 < 4; ++q4) { const f32x4 sv = *(const LAS f32x4*)(s + b * 1024 + slice * 64 + k + 4 * q4);
                            acc[b] += (wv[4 * q4] * sv[0] + wv[4 * q4 + 1] * sv[1]) + (wv[4 * q4 + 2] * sv[2] + wv[4 * q4 + 3] * sv[3]); } } }
            }
            __syncthreads();
#pragma unroll
            for (int b = 0; b < 17; ++b) { f32x4 t = acc[b];
                t[0] += __shfl_xor(t[0], 32); t[1] += __shfl_xor(t[1], 32); t[2] += __shfl_xor(t[2], 32); t[3] += __shfl_xor(t[3], 32);
                if (F.lane < 32) *(LAS f32x4*)(red + (F.wave * 17 + b) * 128 + c4) = t; }
            __syncthreads();
            for (int i = F.tid; i < 17 * 128; i += NTHR) { const int b = i >> 7, cl = i & 127, nn = n0 + cl;
                float sum = F.in[5][l * 12288 + nn];
#pragma unroll
                for (int q2 = 0; q2 < 8; ++q2) sum += red[(q2 * 17 + b) * 128 + cl];
                if (b < 16) WSP(float, WS_SMALL + SM_MODL)[((size_t)l * 16 + b) * 12288 + nn] = sum; else WSP(float, WS_SMALL + SM_MODC)[(size_t)l * 12288 + nn] = sum; }
        }
        __syncthreads();
    }
    {
        LAS float* scr = (LAS float*)(F.lds + F.wave * 16896);
        constexpr int I_WIN = 32 * 115, I_WIN8 = 16 * 115, I_UQ = 8 * 36, I_UKV = 8 * 48, I_WOUT = 32 * 64;
        constexpr int I_WIN_L0 = (I8_INPROJ & 1) ? 0 : I_WIN, I_WIN_L1 = (I8_INPROJ & 2) ? 0 : (FP8_INPROJ_L1 ? I_WIN8 : I_WIN);
        constexpr int I_L0 = I_WIN_L0 + I_UQ + I_UKV + I_WOUT, I_L1 = I_WIN_L1 + I_UQ + I_UKV + I_WOUT;
        constexpr int I_GU16 = 32 * 176, I_DN16 = 88 * 64, I_GU8 = 16 * 176, I_DN8 = 44 * 64;
        constexpr int I_DGU = I8_DENSE_GU ? 0 : (FP8_DENSE_GU ? I_GU8 : I_GU16), I_DDN = FP8_DENSE_DN ? I_DN8 : I_DN16;
        constexpr int I_DENSE = 2 * I_DGU + I_DDN;
        constexpr int NITEMS = I_L0 + I_L1 + I_DENSE;
        for (int it = gw; it < NITEMS; it += NGW) {
            int r = it;
            if (r < I_DENSE) {
                if (r < 2 * I_DGU) { const int up = r >= I_DGU; r -= up * I_DGU;
                    if constexpr (FP8_DENSE_GU != 0) tr_item8(F.in[24 + up], 2048, FF, F.ws + WS_WGU, 3 + up, scr, r, F.lane); else tr_item(F.in[24 + up], 2048, FF, WSP(bf16_t, WS_WGU), 3 + up, nullptr, scr, r, F.lane); continue; }
                r -= 2 * I_DGU;
                if constexpr (FP8_DENSE_DN != 0) tr_item8(F.in[26], FF, 2048, F.ws + WS_WDN, 0, scr, r, F.lane); else tr_item(F.in[26], FF, 2048, WSP(bf16_t, WS_WDN), 0, nullptr, scr, r, F.lane);
                continue; }
            r -= I_DENSE;
            { const int l = r >= I_L0 ? 1 : 0; r -= l * I_L0; const int iwin = l ? I_WIN_L1 : I_WIN_L0;
                if (r < iwin) { if (l == 1 && FP8_INPROJ_L1) tr_item8(F.in[8] + (size_t)l * 2048 * D_IN, 2048, D_IN, F.ws + WS_WIN + (size_t)l * PC * 2048 * 2, 1, scr, r, F.lane);
                                else tr_item(F.in[8] + (size_t)l * 2048 * D_IN, 2048, D_IN, WSP(bf16_t, WS_WIN) + (size_t)l * PC * 2048, 1, nullptr, scr, r, F.lane); continue; } r -= iwin;
                if (r < I_UQ) { if constexpr (FP8_UQKV != 0) { if (r < 4 * 36) tr_item8(F.in[18] + (size_t)l * 512 * 1152, 512, 1152, F.ws + WS_WUQ + (size_t)l * QC * 512 * 2, 0, scr, r, F.lane, F.in[17] + l * 512); }
                                else tr_item(F.in[18] + (size_t)l * 512 * 1152, 512, 1152, WSP(bf16_t, WS_WUQ) + (size_t)l * QC * 512, 0, F.in[17] + l * 512, scr, r, F.lane); continue; } r -= I_UQ;
                if (r < I_UKV) { if constexpr (FP8_UQKV != 0) { if (r < 4 * 48) tr_item8(F.in[20] + (size_t)l * 512 * 1536, 512, 1536, F.ws + WS_WUKV + (size_t)l * KVC * 512 * 2, 2, scr, r, F.lane, F.in[19] + l * 512); }
                                 else tr_item(F.in[20] + (size_t)l * 512 * 1536, 512, 1536, WSP(bf16_t, WS_WUKV) + (size_t)l * KVC * 512, 2, F.in[19] + l * 512, scr, r, F.lane); continue; } r -= I_UKV;
                if ((FP8_WOUT >> l) & 1) { if (r < 16 * 64) tr_item8(F.in[23] + (size_t)l * 2048 * 2048, 2048, 2048, F.ws + WS_WOUT + (size_t)l * 2048 * 2048 * 2, 0, scr, r, F.lane); }
                else tr_item(F.in[23] + (size_t)l * 2048 * 2048, 2048, 2048, WSP(bf16_t, WS_WOUT) + (size_t)l * 2048 * 2048, 0, nullptr, scr, r, F.lane); }
        }
    }
    {
        constexpr long NC_MOE = I8_MOE_GU ? 16L * FF : 0, NC_DGU = I8_DENSE_GU ? 2L * FF : 0, NC_WIN = ((I8_INPROJ & 1) ? D_IN : 0) + ((I8_INPROJ & 2) ? D_IN : 0);
        for (long t = gthr; t < 2 * (NC_MOE + NC_DGU + NC_WIN); t += nthr) { long c = t >> 1; const int par = (int)(t & 1);
            const float* W; int N, n, kind; float* cs;
            if (c < NC_MOE) { const int mat = (int)(c / FF), e = mat >> 1, up = mat & 1; n = (int)(c % FF); N = FF; kind = 3 + up; W = F.in[28 + up] + (size_t)e * 2048 * FF; cs = WSP(float, WS_SMALL + SM_CS_MGU) + e * 11264; }
            else if ((c -= NC_MOE) < NC_DGU) { const int up = (int)(c / FF); n = (int)(c % FF); N = FF; kind = 3 + up; W = F.in[24 + up]; cs = WSP(float, WS_SMALL + SM_CS_DGU); }
            else { c -= NC_DGU; int l = (int)(c / D_IN); n = (int)(c % D_IN); if ((I8_INPROJ & 3) == 2) l = 1; N = D_IN; kind = 1; W = F.in[8] + (size_t)l * 2048 * D_IN; cs = WSP(float, WS_SMALL + SM_CS_WIN) + l * PC; }
            float mx = 0.f;
            for (int k0 = par * 16; k0 < 2048; k0 += 512) { float v[16];
#pragma unroll
                for (int i2 = 0; i2 < 16; ++i2) v[i2] = fabsf(W[(size_t)(k0 + 32 * i2) * N + n]);
#pragma unroll
                for (int i2 = 0; i2 < 16; ++i2) mx = fmaxf(mx, v[i2]); }
            mx = fmaxf(mx, __shfl_xor(mx, 1));
            if (par == 0) cs[col_map(kind, n)] = fmaxf(mx, 1e-30f) * (1.35f / 127.0f); }
        for (int l = 0; l < 2; ++l) if ((I8_INPROJ >> l) & 1) { float* csw = WSP(float, WS_SMALL + SM_CS_WIN) + l * PC; for (long i2 = gthr; i2 < PC - D_IN; i2 += nthr) csw[D_IN + i2] = 1.0f; }
    }
    for (int l = 0; l < 2; ++l) {
        zero_rows(WSP(bf16_t, WS_WIN) + (size_t)l * PC * 2048, ((l == 1 && FP8_INPROJ_L1) || ((I8_INPROJ >> l) & 1)) ? 1024 : 2048, D_IN, PC, gthr, nthr);
        constexpr int KZ = FP8_UQKV ? 256 : 512;
        zero_rows(WSP(bf16_t, WS_WUQ) + (size_t)l * QC * 512, KZ, 1152, QC, gthr, nthr);
        for (int h = 0; h < 6; ++h) zero_rows(WSP(bf16_t, WS_WUKV) + (size_t)l * KVC * 512, KZ, h * 320 + 128, h * 320 + 192, gthr, nthr);
        zero_rows(WSP(bf16_t, WS_WUKV) + (size_t)l * KVC * 512, KZ, 1920, KVC, gthr, nthr);
    }
    for (int i = gthr; i < 2 * 512 * 512; i += nthr) { const int l = i >> 18, dg = (i >> 9) & 511, cg = i & 511; const int g = dg >> 7, d = dg & 127;
        float v = 0.f; if ((cg >> 7) == g) v = F.in[15][((size_t)(l * 4 + g) * 128 + (cg & 127)) * 128 + d] * F.in[16][l * 512 + dg];
        WSP(bf16_t, WS_SMALL + SM_POOLB)[i] = f2bf(v); }
    for (int i = gthr; i < 64 * 16; i += nthr) { const int pos = i >> 4, j = i & 15; const float inv = exp2f(-(float)j * (13.287712379549449f / 16.0f)); const float ang = (float)pos * inv;
        const float kf = rintf(ang * 0.15915494309189535f); float r = fmaf(-kf, 6.2831854820251465f, ang); r = fmaf(-kf, -1.7484555e-07f, r);
        WSP(float, WS_SMALL + SM_ROPE)[i * 2] = cosf(r); WSP(float, WS_SMALL + SM_ROPE)[i * 2 + 1] = sinf(r); }
}

template <bool ROUTER, int OUTM = 0, bool IN16 = false>
__device__ __forceinline__ void phase_norm(Frame& F, const float* hL, const float* hC, const float* nw, int layer, int shift_idx, int nrows) {
    const int gw = F.bid * NWAVES + F.wave, NGW = F.G * NWAVES;
    const float* modL = WSP(float, WS_SMALL + SM_MODL) + (size_t)layer * 16 * 12288;
    const float* modC = WSP(float, WS_SMALL + SM_MODC) + (size_t)layer * 12288;
    bf16_t* U = WSP(bf16_t, WS_U);
    LAS float* wr = (LAS float*)F.lds;
    if constexpr (ROUTER) { for (int i = F.tid; i < 2048 * 8; i += NTHR) wr[i] = F.in[27][i]; __syncthreads(); }
    int ecnt[8];
#pragma unroll
    for (int e = 0; e < 8; ++e) ecnt[e] = 0;
    for (int r = gw; r < nrows; r += NGW) {
        const bool lat = r < TL;
        const float* hrow = lat ? hL + (size_t)r * DM : hC + (size_t)(r - TL) * DM;
        const float* mod = lat ? modL + (size_t)(r >> 11) * 12288 : modC;
        const f32x4* xr = (const f32x4*)hrow + F.lane; const u32x2* xr16 = (const u32x2*)(WSP(bf16_t, WS_H16) + (size_t)r * DM) + F.lane;
        f32x4 v[8]; float ss = 0.f;
#pragma unroll
        for (int j = 0; j < 8; ++j) { if constexpr (IN16) { const u32x2 w = xr16[64 * j]; v[j] = (f32x4){bf_lo(w.x), bf_hi(w.x), bf_lo(w.y), bf_hi(w.y)}; } else v[j] = xr[64 * j];
            ss += (v[j][0] * v[j][0] + v[j][1] * v[j][1]) + (v[j][2] * v[j][2] + v[j][3] * v[j][3]); }
        const float rstd = rsqrtf(wave_sum(ss) * (1.0f / DM) + EPS);
        u32x2* o8 = (u32x2*)(U + (size_t)r * DM) + F.lane;
#pragma unroll
        for (int j = 0; j < 8; ++j) {
            const f32x4 w4 = *((const f32x4*)nw + F.lane + 64 * j), sh = *((const f32x4*)(mod + shift_idx * DM) + F.lane + 64 * j), sc = *((const f32x4*)(mod + (shift_idx + 1) * DM) + F.lane + 64 * j);
            v[j] = (v[j] * rstd * w4) * (sc + 1.0f) + sh;
            if constexpr (OUTM == 1) ((unsigned*)((unsigned char*)U + (size_t)r * DM))[F.lane + 64 * j] = pack4_fp8(v[j][0], v[j][1], v[j][2], v[j][3]);
            else if constexpr (OUTM == 0) { u32x2 w; w.x = cvt_pk_bf16(v[j][0], v[j][1]); w.y = cvt_pk_bf16(v[j][2], v[j][3]); o8[64 * j] = w; }
        }
        if constexpr (OUTM == 2) {
            float am = 0.f;
#pragma unroll
            for (int j = 0; j < 8; ++j) am = fmaxf(am, fmaxf(fmaxf(fabsf(v[j][0]), fabsf(v[j][1])), fmaxf(fabsf(v[j][2]), fabsf(v[j][3]))));
#pragma unroll
            for (int o = 1; o < 64; o <<= 1) am = fmaxf(am, __shfl_xor(am, o));
            am = fmaxf(am, 1e-30f); const float inv = 127.0f / am;
#pragma unroll
            for (int j = 0; j < 8; ++j) ((unsigned*)((unsigned char*)U + (size_t)r * DM))[F.lane + 64 * j] = pack4_i8(v[j][0] * inv, v[j][1] * inv, v[j][2] * inv, v[j][3] * inv);
            if (F.lane == 0) WSP(float, WS_SMALL + SM_RS)[r] = am * (1.0f / 127.0f);
        }
        if constexpr (ROUTER) {
            float lg[8];
#pragma unroll
            for (int e = 0; e < 8; ++e) lg[e] = 0.f;
#pragma unroll
            for (int j = 0; j < 8; ++j) { asm volatile("" ::: "memory");
#pragma unroll
                for (int i = 0; i < 4; ++i) { const int idx = 256 * j + 4 * F.lane + i; const f32x4 wa = *(const LAS f32x4*)(wr + idx * 8), wb = *(const LAS f32x4*)(wr + idx * 8 + 4); const float x = v[j][i];
                    lg[0] += x * wa[0]; lg[1] += x * wa[1]; lg[2] += x * wa[2]; lg[3] += x * wa[3]; lg[4] += x * wb[0]; lg[5] += x * wb[1]; lg[6] += x * wb[2]; lg[7] += x * wb[3]; } }
#pragma unroll
            for (int e = 0; e < 8; ++e) lg[e] = wave_sum(lg[e]);
            int i1 = 0; float v1 = lg[0];
#pragma unroll
            for (int e = 1; e < 8; ++e) if (lg[e] > v1) { v1 = lg[e]; i1 = e; }
            int i2 = -1; float v2 = -3.0e38f;
#pragma unroll
            for (int e = 0; e < 8; ++e) if (e != i1 && lg[e] > v2) { v2 = lg[e]; i2 = e; }
            const float ex = __expf(v2 - v1), g1 = 1.0f / (1.0f + ex), g2 = ex * g1;
#pragma unroll
            for (int e = 0; e < 8; ++e) ecnt[e] += (i1 == e) + (i2 == e);
            if (F.lane == 0) { int* ti = WSP(int, WS_SMALL + SM_TOPI) + (size_t)r * 2; float* tw = WSP(float, WS_SMALL + SM_TOPW) + (size_t)r * 2; ti[0] = i1; ti[1] = i2; tw[0] = g1; tw[1] = g2; }
        }
    }
    if constexpr (ROUTER) { if (F.lane == 0) { int* cw = WSP(int, WS_SMALL + SM_CNTW) + (size_t)gw * 8;
#pragma unroll
            for (int e = 0; e < 8; ++e) cw[e] = ecnt[e]; }
        __syncthreads(); }
}

__device__ __forceinline__ void unpack8(const u32x4 w, float (&x)[8]) { x[0] = bf_lo(w.x); x[1] = bf_hi(w.x); x[2] = bf_lo(w.y); x[3] = bf_hi(w.y); x[4] = bf_lo(w.z); x[5] = bf_hi(w.z); x[6] = bf_lo(w.w); x[7] = bf_hi(w.w); }
__device__ __forceinline__ u32x4 pack8(const float (&x)[8]) { u32x4 w; w.x = cvt_pk_bf16(x[0], x[1]); w.y = cvt_pk_bf16(x[2], x[3]); w.z = cvt_pk_bf16(x[4], x[5]); w.w = cvt_pk_bf16(x[6], x[7]); return w; }
__device__ __forceinline__ void phase_conv_pool(Frame& F, int layer) {
    const long gthr = (long)F.bid * NTHR + F.tid, nthr = (long)F.G * NTHR;
    const bf16_t* P = WSP(bf16_t, WS_P); bf16_t* XA = WSP(bf16_t, WS_XA); bf16_t* PL = WSP(bf16_t, WS_PL); float* DT = WSP(float, WS_SMALL + SM_DT);
    const float* cw = F.in[9] + (size_t)layer * 4 * XAC; const float* cb = F.in[10] + (size_t)layer * XAC; const float* dtb = F.in[11] + layer * 24;
    constexpr long NCONV = (long)(TT / 16) * 160, NPOOL = (long)(TT / 16) * 64;
    for (long it = gthr; it < NCONV + NPOOL; it += nthr) {
      if (it < NCONV) {
        const int r0 = (TT / 16 - 1 - (int)(it / 160)) * 16, ch = (int)(it % 160) * 8;
        const int t0 = r0 < TL ? (r0 & 2047) : ((r0 - TL) & 255), n = r0 < TL ? SEQ : CTXL;
        float w[4][8], bs[8];
#pragma unroll
        for (int k = 0; k < 4; ++k) { const f32x4 a = *(const f32x4*)(cw + k * XAC + ch), b = *(const f32x4*)(cw + k * XAC + ch + 4); w[k][0] = a[0]; w[k][1] = a[1]; w[k][2] = a[2]; w[k][3] = a[3]; w[k][4] = b[0]; w[k][5] = b[1]; w[k][6] = b[2]; w[k][7] = b[3]; }
        { const f32x4 a = *(const f32x4*)(cb + ch), b = *(const f32x4*)(cb + ch + 4); bs[0] = a[0]; bs[1] = a[1]; bs[2] = a[2]; bs[3] = a[3]; bs[4] = b[0]; bs[5] = b[1]; bs[6] = b[2]; bs[7] = b[3]; }
        const bf16_t* src = P + (size_t)r0 * PC + PXBC + ch;
        u32x4 raw[19];
#pragma unroll
        for (int i = 0; i < 19; ++i) { const int tt = t0 - 2 + i; raw[i] = (tt >= 0 && tt < n) ? *(const u32x4*)(src + (long)(i - 2) * PC) : (u32x4){0u, 0u, 0u, 0u}; }
        float x0[8], x1[8], x2[8], x3[8];
        unpack8(raw[0], x0); unpack8(raw[1], x1); unpack8(raw[2], x2);
#pragma unroll
        for (int i = 0; i < 16; ++i) { unpack8(raw[i + 3], x3); float acc[8];
#pragma unroll
            for (int e = 0; e < 8; ++e) { acc[e] = bs[e] + w[0][e] * x0[e] + w[1][e] * x1[e] + w[2][e] * x2[e] + w[3][e] * x3[e]; acc[e] = silu_f(acc[e]); x0[e] = x1[e]; x1[e] = x2[e]; x2[e] = x3[e]; }
            *(u32x4*)(XA + (size_t)(r0 + i) * XAC + ch) = pack8(acc); }
      } else {
        const long ip = it - NCONV;
        const int r0 = (TT / 16 - 1 - (int)(ip >> 6)) * 16, ck = (int)(ip & 63), ch = ck * 8, w = 2 << (ck >> 4), hw = w >> 1;
        const int t0 = r0 < TL ? (r0 & 2047) : ((r0 - TL) & 255), n = r0 < TL ? SEQ : CTXL;
        const bf16_t* src = P + (size_t)(r0 - t0) * PC + PPOOL + ch;
        int lo = t0 - hw, hi = lo + w; lo = lo < 0 ? 0 : lo; hi = hi > n ? n : hi;
        float sm[8];
#pragma unroll
        for (int e = 0; e < 8; ++e) sm[e] = 0.f;
        { u32x4 wr_[16];
#pragma unroll
          for (int k = 0; k < 16; ++k) wr_[k] = (lo + k < hi) ? *(const u32x4*)(src + (size_t)(lo + k) * PC) : (u32x4){0u, 0u, 0u, 0u};
#pragma unroll
          for (int k = 0; k < 16; ++k) { float x[8]; unpack8(wr_[k], x);
#pragma unroll
              for (int e = 0; e < 8; ++e) sm[e] += x[e]; } }
#pragma unroll 4
        for (int i = 0; i < 16; ++i) { const int t = t0 + i; float u[8], o[8]; unpack8(*(const u32x4*)(src + (size_t)t * PC), u);
            int l2 = t - hw, h2 = l2 + w; l2 = l2 < 0 ? 0 : l2; h2 = h2 > n ? n : h2;
            const float inv = __builtin_amdgcn_rcpf((float)(h2 - l2));
#pragma unroll
            for (int e = 0; e < 8; ++e) o[e] = sm[e] * inv - u[e];
            *(f32x4*)(PL + (size_t)(r0 + i) * 512 + ch) = __builtin_bit_cast(f32x4, pack8(o));
            const int ta = t + 1 - hw + w - 1, tr = t - hw;
            if (ta < n) { float x[8]; unpack8(*(const u32x4*)(src + (size_t)ta * PC), x);
#pragma unroll
                for (int e = 0; e < 8; ++e) sm[e] += x[e]; }
            if (tr >= 0) { float x[8]; unpack8(*(const u32x4*)(src + (size_t)tr * PC), x);
#pragma unroll
                for (int e = 0; e < 8; ++e) sm[e] -= x[e]; } }
      }
    }
    for (long it = gthr; it < (long)TT * 24; it += nthr) { const int r = (int)(it / 24), j = (int)(it % 24);
        const float x = bf2f(P[(size_t)r * PC + PDT + j]) + dtb[j]; DT[it] = fmaxf(x, 0.f) + log1pf(__expf(-fabsf(x))); }
}

__device__ __forceinline__ void phase_ssd_naive(Frame& F, int layer) {
    const bf16_t* XA = WSP(bf16_t, WS_XA); const float* DT = WSP(float, WS_SMALL + SM_DT);
    for (int u = F.bid + F.G * F.wave; u < NB * 24; u += F.G * NWAVES) {
        const int b = u / 24, rem = u % 24, head = rem >> 1, dir = rem & 1, g = head / 6;
        const float a = -__expf(F.in[12][layer * 24 + dir * 12 + head]);
        bf16_t* Y = dir ? WSP(bf16_t, WS_YB) : WSP(bf16_t, WS_YF);
        float h[128];
#pragma unroll
        for (int n = 0; n < 128; ++n) h[n] = 0.f;
        for (int step = 0; step < CTXL + SEQ; ++step) {
            int row;
            if (step < CTXL) { const int t = dir ? CTXL - 1 - step : step; row = TL + b * CTXL + t; }
            else { const int s2 = step - CTXL, t = dir ? SEQ - 1 - s2 : s2; row = b * SEQ + t; }
            const float dtv = DT[(size_t)row * 24 + dir * 12 + head], dA = __expf(a * dtv);
            const float dtx = dtv * bf2f(XA[(size_t)row * XAC + head * 64 + F.lane]);
            const u32x4* Bp = (const u32x4*)(XA + (size_t)row * XAC + 768 + g * 128); const u32x4* Cp = (const u32x4*)(XA + (size_t)row * XAC + 1024 + g * 128);
            float y = 0.f;
#pragma unroll
            for (int n8 = 0; n8 < 16; ++n8) { float bv[8], cv[8]; unpack8(Bp[n8], bv); unpack8(Cp[n8], cv);
#pragma unroll
                for (int i = 0; i < 8; ++i) { h[n8 * 8 + i] = h[n8 * 8 + i] * dA + dtx * bv[i]; y += cv[i] * h[n8 * 8 + i]; } }
            Y[(size_t)row * 768 + head * 64 + F.lane] = f2bf(y);
        }
    }
}

namespace ssd {
constexpr int LD = 144;
constexpr int LDX = 80;
constexpr int OFF_C = 0, OFF_B = 36864, OFF_XD = 73728, OFF_XDD = 94208, OFF_H = 114688, OFF_ACS = 147456 + 256;
typedef short v4i16_t __attribute__((ext_vector_type(4)));
__device__ __forceinline__ bf16x8 tr2(const LAS unsigned char* p0, const LAS unsigned char* p1) {
    const v4i16_t a = __builtin_amdgcn_ds_read_tr16_b64_v4i16((LAS v4i16_t*)p0), b = __builtin_amdgcn_ds_read_tr16_b64_v4i16((LAS v4i16_t*)p1);
    return (bf16x8){a[0], a[1], a[2], a[3], b[0], b[1], b[2], b[3]};
}
template <int NP>
__device__ __forceinline__ void chunk_math(const LAS bf16_t* Cs, const LAS bf16_t* Bs, const LAS bf16_t* Hb, const LAS unsigned char* trXd, const LAS unsigned char* trXdd, const LAS unsigned char* trB,
                                           const LAS float* acs, int lb, int fr, int fq, int fo, f32x4 (&sacc)[4], f32x4 (&yout)[4]) {
#define FRAG(base, row0, ks) (*(const LAS bf16x8*)((base) + (row0) * LD + fo + (ks) * 32))
    bf16x8 fc[4];
#pragma unroll
    for (int ks = 0; ks < 4; ++ks) fc[ks] = FRAG(Cs, lb * 16, ks);
    const int l = lb * 16 + fr; const float al = acs[l];
    bf16x8 fbt[4];
#pragma unroll
    for (int ks = 0; ks < 4; ++ks) fbt[ks] = tr2(trB + (ks * 32 * LD) * 2, trB + ((ks * 32 + 4) * LD) * 2);
    f32x4 yo[4];
#pragma unroll
    for (int pt = 0; pt < 4; ++pt) { yo[pt] = (f32x4){0.f, 0.f, 0.f, 0.f}; sacc[pt] = (f32x4){0.f, 0.f, 0.f, 0.f};
        bf16x8 fx[4], fh[4];
#pragma unroll
        for (int ks = 0; ks < 4; ++ks) { fh[ks] = FRAG(Hb, pt * 16, ks); fx[ks] = tr2(trXdd + (ks * 32 * LDX + pt * 16) * 2, trXdd + ((ks * 32 + 4) * LDX + pt * 16) * 2); }
#pragma unroll
        for (int ks = 0; ks < 4; ++ks) { yo[pt] = __builtin_amdgcn_mfma_f32_16x16x32_bf16(fh[ks], fc[ks], yo[pt], 0, 0, 0);
            sacc[pt] = __builtin_amdgcn_mfma_f32_16x16x32_bf16(fbt[ks], fx[ks], sacc[pt], 0, 0, 0); }
        __builtin_amdgcn_sched_barrier(0); }
    const float el = __expf(al);
#pragma unroll
    for (int pt = 0; pt < 4; ++pt) yout[pt] = yo[pt] * el;
#pragma unroll
    for (int j = 0; j < NP; ++j) {
        float gv[8];
#pragma unroll
        for (int h = 0; h < 2; ++h) { const int t = 2 * j + h; bf16x8 fb[4];
#pragma unroll
            for (int ks = 0; ks < 4; ++ks) fb[ks] = FRAG(Bs, t * 16, ks);
            f32x4 cb = (f32x4){0.f, 0.f, 0.f, 0.f};
#pragma unroll
            for (int ks = 0; ks < 4; ++ks) cb = __builtin_amdgcn_mfma_f32_16x16x32_bf16(fb[ks], fc[ks], cb, 0, 0, 0);
            const f32x4 as4 = *(const LAS f32x4*)(acs + t * 16 + 4 * fq);
#pragma unroll
            for (int jj = 0; jj < 4; ++jj) gv[4 * h + jj] = (t * 16 + 4 * fq + jj <= l) ? cb[jj] * __expf(al - as4[jj]) : 0.f; }
        const u32x4 gp = (u32x4){cvt_pk_bf16(gv[0], gv[1]), cvt_pk_bf16(gv[2], gv[3]), cvt_pk_bf16(gv[4], gv[5]), cvt_pk_bf16(gv[6], gv[7])}; const bf16x8 fg = __builtin_bit_cast(bf16x8, gp);
#pragma unroll
        for (int pt = 0; pt < 4; ++pt) { const bf16x8 fx = tr2(trXd + ((2 * j) * 16 * LDX + pt * 16) * 2, trXd + ((2 * j + 1) * 16 * LDX + pt * 16) * 2);
            yout[pt] = __builtin_amdgcn_mfma_f32_16x16x32_bf16(fx, fg, yout[pt], 0, 0, 0); }
        __builtin_amdgcn_sched_barrier(0); }
#undef FRAG
}
}
__device__ __forceinline__ void phase_ssd(Frame& F, int layer) {
    using namespace ssd;
    const bf16_t* XA = WSP(bf16_t, WS_XA); const float* DT = WSP(float, WS_SMALL + SM_DT);
    LAS bf16_t* Cs = (LAS bf16_t*)(F.lds + OFF_C); LAS bf16_t* Bs = (LAS bf16_t*)(F.lds + OFF_B); LAS bf16_t* Xd = (LAS bf16_t*)(F.lds + OFF_XD);
    LAS bf16_t* Xdd = (LAS bf16_t*)(F.lds + OFF_XDD); LAS bf16_t* Hb = (LAS bf16_t*)(F.lds + OFF_H);
    LAS float* acs0 = (LAS float*)(F.lds + OFF_ACS);
    const int tid = F.tid, lane = F.lane, w = F.wave, fr = lane & 15, fq = lane >> 4;
    const int fo = fr * LD + fq * 8;
    const int lb = w < 4 ? w : 11 - w;
    const int tq = fr >> 2, tp = fr & 3;
    const LAS unsigned char* trXd = (const LAS unsigned char*)Xd + ((4 * fq + tq) * LDX + 4 * tp) * 2;
    const LAS unsigned char* trXdd = (const LAS unsigned char*)Xdd + ((8 * fq + tq) * LDX + 4 * tp) * 2;
    const LAS unsigned char* trB = (const LAS unsigned char*)Bs + ((8 * fq + tq) * LD + w * 16 + 4 * tp) * 2;
    for (int uu_ = F.bid; uu_ < NB * 24 * SSD_REP; uu_ += F.G) {
        const int u = uu_ % (NB * 24);
        const int b = u / 24, rem = u % 24, head = rem >> 1, dir = rem & 1, g = head / 6;
        const float a = -__expf(F.in[12][layer * 24 + dir * 12 + head]);
        bf16_t* Y = dir ? WSP(bf16_t, WS_YB) : WSP(bf16_t, WS_YF);
        const int sgn = dir ? -1 : 1;
        f32x4 hreg[4];
#pragma unroll
        for (int pt = 0; pt < 4; ++pt) hreg[pt] = (f32x4){0.f, 0.f, 0.f, 0.f};
        __syncthreads();
        for (int i = tid; i < 64 * LD / 2; i += NTHR) ((LAS unsigned*)Hb)[i] = 0u;
#define RBASE(c) ((c) < 2 ? (dir ? TL + b * CTXL + CTXL - 1 - (c) * 128 : TL + b * CTXL + (c) * 128) : (dir ? b * SEQ + SEQ - 1 - ((c) - 2) * 128 : b * SEQ + ((c) - 2) * 128))
        struct Raw { u32x4 rB[4], rC[4], rX[2]; float dt0, dt1; };
        Raw RA, RBs; RA.dt0 = RA.dt1 = RBs.dt0 = RBs.dt1 = 0.f;
#define SSD_LOAD(S, c) do { const int _rb = RBASE(c); \
        _Pragma("unroll") for (int i = 0; i < 4; ++i) { const int q_ = tid + 512 * i, s_ = q_ >> 4, ch = q_ & 15; const bf16_t* rp = XA + (size_t)(_rb + sgn * s_) * XAC;     \
            S.rB[i] = *(const u32x4*)(rp + 768 + g * 128 + ch * 8); S.rC[i] = *(const u32x4*)(rp + 1024 + g * 128 + ch * 8); } \
        _Pragma("unroll") for (int i = 0; i < 2; ++i) { const int q_ = tid + 512 * i, s_ = q_ >> 3, ch = q_ & 7; S.rX[i] = *(const u32x4*)(XA + (size_t)(_rb + sgn * s_) * XAC + head * 64 + ch * 8); } \
        S.dt0 = DT[(size_t)(_rb + sgn * (2 * lane)) * 24 + dir * 12 + head]; S.dt1 = DT[(size_t)(_rb + sgn * (2 * lane + 1)) * 24 + dir * 12 + head]; } while (0)
        SSD_LOAD(RA, 0);
        SSD_LOAD(RBs, 1);
#define SSD_SCAN(S, buf) do { if (w == 0) { const float sm = S.dt0 + S.dt1; float incl = sm; \
            _Pragma("unroll") for (int o = 1; o < 64; o <<= 1) { const float t = __shfl_up(incl, o); if (lane >= o) incl += t; } \
            const float excl = incl - sm; LAS float* ac_ = acs0 + (buf) * 256; LAS float* dt_ = ac_ + 128; \
            ac_[2 * lane] = a * (excl + S.dt0); ac_[2 * lane + 1] = a * incl; dt_[2 * lane] = S.dt0; dt_[2 * lane + 1] = S.dt1; } } while (0)
        SSD_SCAN(RA, 0);
        __syncthreads();
        auto chunk = [&](const int c, Raw& S, const Raw& T) __attribute__((always_inline)) {
            LAS float* acs = acs0 + (c & 1) * 256; LAS float* dts = acs + 128;
            const float acs_last = acs[127];
#pragma unroll
            for (int i = 0; i < 4; ++i) { const int q_ = tid + 512 * i, s_ = q_ >> 4, ch = q_ & 15;
                *(LAS u32x4*)(Cs + s_ * LD + ch * 8) = S.rC[i]; *(LAS u32x4*)(Bs + s_ * LD + ch * 8) = S.rB[i]; }
#pragma unroll
            for (int i = 0; i < 2; ++i) { const int q_ = tid + 512 * i, s_ = q_ >> 3, ch = q_ & 7; const float dv = dts[s_], es = __expf(acs_last - acs[s_]); float xv[8]; unpack8(S.rX[i], xv);
#pragma unroll
                for (int e = 0; e < 8; ++e) xv[e] *= dv;
                *(LAS u32x4*)(Xd + s_ * LDX + ch * 8) = pack8(xv);
#pragma unroll
                for (int e = 0; e < 8; ++e) xv[e] *= es;
                *(LAS u32x4*)(Xdd + s_ * LDX + ch * 8) = pack8(xv); }
            SSD_LOAD(S, (c + 2 < 18 ? c + 2 : 17));
            __syncthreads();
            f32x4 sacc[4], yv[4];
            switch (lb >> 1) {
                case 0: chunk_math<1>(Cs, Bs, Hb, trXd, trXdd, trB, acs, lb, fr, fq, fo, sacc, yv); break;
                case 1: chunk_math<2>(Cs, Bs, Hb, trXd, trXdd, trB, acs, lb, fr, fq, fo, sacc, yv); break;
                case 2: chunk_math<3>(Cs, Bs, Hb, trXd, trXdd, trB, acs, lb, fr, fq, fo, sacc, yv); break;
                default: chunk_math<4>(Cs, Bs, Hb, trXd, trXdd, trB, acs, lb, fr, fq, fo, sacc, yv); break;
            }
            { bf16_t* ydst = Y + (size_t)(RBASE(c) + sgn * (lb * 16 + fr)) * 768 + head * 64 + 4 * fq;
#pragma unroll
              for (int pt = 0; pt < 4; ++pt) { u32x2 o; o.x = cvt_pk_bf16(yv[pt][0], yv[pt][1]); o.y = cvt_pk_bf16(yv[pt][2], yv[pt][3]); *(u32x2*)(ydst + pt * 16) = o; } }
            if (c + 1 < 18) SSD_SCAN(T, (c + 1) & 1);
            __syncthreads();
            { const float ea = __expf(acs_last);
#pragma unroll
              for (int pt = 0; pt < 4; ++pt) { hreg[pt] = hreg[pt] * ea + sacc[pt];
                  u32x2 o; o.x = cvt_pk_bf16(hreg[pt][0], hreg[pt][1]); o.y = cvt_pk_bf16(hreg[pt][2], hreg[pt][3]); *(LAS u32x2*)(Hb + (pt * 16 + fr) * LD + w * 16 + 4 * fq) = o; } }
        };
        for (int c = 0; c < 18; c += 2) { chunk(c, RA, RBs); chunk(c + 1, RBs, RA); }
#undef RBASE
#undef SSD_LOAD
#undef SSD_SCAN
#undef FRAG
    }
    __syncthreads();
}

__device__ __forceinline__ void phase_qkv_final(Frame& F, int layer) {
    const int gw = F.bid * NWAVES + F.wave, NGW = F.G * NWAVES, lane = F.lane;
    const bf16_t* P = WSP(bf16_t, WS_P); bf16_t* QR = WSP(bf16_t, WS_QR); bf16_t* KV = WSP(bf16_t, WS_KVR);
    const float* tab = WSP(float, WS_SMALL + SM_ROPE);
    const int hs = lane >> 5, ck = lane & 31; const bool act = ck < 24, rp = ck >= 16 && act;
    float qw[8], kw[8];
    { const float* a = F.in[21] + layer * 192 + (act ? ck : 0) * 8; const float* b = F.in[22] + layer * 192 + (act ? ck : 0) * 8;
#pragma unroll
      for (int e = 0; e < 8; ++e) { qw[e] = a[e]; kw[e] = b[e]; } }
    const int ra = (ck - 16) >> 2, rj0 = ((ck - 16) & 1) * 8; const bool rhi = ((ck - 16) >> 1) & 1;
#if FP8_PV
    LAS unsigned char* Vs = F.lds;
    __syncthreads();
    const int nlat = TL / 64, nctx = TC / 64, Lr = (nlat + F.G - 1) / F.G, Cr = (nctx + F.G - 1) / F.G;
    for (int rd = 0; rd < Lr + Cr; ++rd) {
        int tl;
        if (rd < Lr) { tl = F.bid + rd * F.G; if (tl >= nlat) continue; }
        else { const int jc = (F.G - 1 - F.bid) + (rd - Lr) * F.G; if (jc >= nctx) continue; tl = nlat + jc; }
    for (int rr_ = 0; rr_ < 8; ++rr_) { const int r = tl * 64 + F.wave * 8 + rr_;
#else
    for (int r = gw; r < TT; r += NGW) {
#endif
        const bool lat = r < TL; const int t = lat ? (r & 2047) : 0;
        float x[8]; float ss = 0.f;
        unpack8(*(const u32x4*)(P + (size_t)r * PC + PCQ + lane * 8), x);
#pragma unroll
        for (int e = 0; e < 8; ++e) ss += x[e] * x[e];
        const float rq = rsqrtf(wave_sum(ss) * (1.0f / 512.0f) + EPS);
        unpack8(*(const u32x4*)(P + (size_t)r * PC + PCKV + lane * 8), x); ss = 0.f;
#pragma unroll
        for (int e = 0; e < 8; ++e) ss += x[e] * x[e];
        const float rkv = rsqrtf(wave_sum(ss) * (1.0f / 512.0f) + EPS);
        float cs[8], sn[8];
        if (rp && lat) { const int pos = ra ? (t & 63) : (t >> 6); const f32x4* tp = (const f32x4*)(tab + (pos * 16 + rj0) * 2);
#pragma unroll
            for (int q = 0; q < 4; ++q) { const f32x4 v = tp[q]; cs[2 * q] = v[0]; sn[2 * q] = v[1]; cs[2 * q + 1] = v[2]; sn[2 * q + 1] = v[3]; } }
        else {
#pragma unroll
            for (int e = 0; e < 8; ++e) { cs[e] = 1.f; sn[e] = 0.f; } }
        if (lat || layer == 0) {
            bf16_t* q = QR + (size_t)r * QC;
            u32x4 rawq[3];
#pragma unroll
            for (int ps = 0; ps < 3; ++ps) rawq[ps] = act ? *(const u32x4*)(q + (ps * 2 + hs) * 192 + ck * 8) : (u32x4){0u, 0u, 0u, 0u};
#pragma unroll
            for (int ps = 0; ps < 3; ++ps) { bf16_t* qp = q + (ps * 2 + hs) * 192 + ck * 8; float a[8]; float s2 = 0.f;
                if (act) unpack8(rawq[ps], a); else {
#pragma unroll
                    for (int e = 0; e < 8; ++e) a[e] = 0.f; }
#pragma unroll
                for (int e = 0; e < 8; ++e) { a[e] *= rq; s2 += a[e] * a[e]; }
#pragma unroll
                for (int o = 1; o < 32; o <<= 1) s2 += __shfl_xor(s2, o);
                const float rs = rsqrtf(s2 * (1.0f / 192.0f) + EPS) * ATT_QKFOLD;
#pragma unroll
                for (int e = 0; e < 8; ++e) { a[e] *= rs * qw[e]; const float pr = __shfl_xor(a[e], 2); a[e] = rhi ? a[e] * cs[e] + pr * sn[e] : a[e] * cs[e] - pr * sn[e]; }
#if FP8_QK
                if (act) { u32x2 w8; w8.x = pack4_fp8(a[0], a[1], a[2], a[3]); w8.y = pack4_fp8(a[4], a[5], a[6], a[7]); *(u32x2*)((unsigned char*)q + (ps * 2 + hs) * 192 + ck * 8) = w8; }
#else
                if (act) *(u32x4*)qp = pack8(a);
#endif
            }
        }
        bf16_t* kv = KV + (size_t)r * KVC;
        u32x4 rawk[3];
#pragma unroll
        for (int ps = 0; ps < 3; ++ps) rawk[ps] = act ? (rp ? *(const u32x4*)(P + (size_t)r * PC + PKR + (ck - 16) * 8) : *(const u32x4*)(kv + (ps * 2 + hs) * 320 + ck * 8)) : (u32x4){0u, 0u, 0u, 0u};
#pragma unroll
        for (int ps = 0; ps < 3; ++ps) { bf16_t* kp = kv + (ps * 2 + hs) * 320 + ck * 8; float a[8]; float s2 = 0.f;
            if (act) unpack8(rawk[ps], a); else {
#pragma unroll
                for (int e = 0; e < 8; ++e) a[e] = 0.f; }
            const float sc = rp ? 1.f : rkv;
#pragma unroll
            for (int e = 0; e < 8; ++e) { a[e] *= sc; s2 += a[e] * a[e]; }
#pragma unroll
            for (int o = 1; o < 32; o <<= 1) s2 += __shfl_xor(s2, o);
            const float rs = rsqrtf(s2 * (1.0f / 192.0f) + EPS) * ATT_QKFOLD;
#pragma unroll
            for (int e = 0; e < 8; ++e) { a[e] *= rs * kw[e]; const float pr = __shfl_xor(a[e], 2); a[e] = rhi ? a[e] * cs[e] + pr * sn[e] : a[e] * cs[e] - pr * sn[e]; }
#if FP8_QK
            if (act) { u32x2 w8; w8.x = pack4_fp8(a[0], a[1], a[2], a[3]); w8.y = pack4_fp8(a[4], a[5], a[6], a[7]); *(u32x2*)((unsigned char*)(kv + (ps * 2 + hs) * 320) + ck * 8) = w8; }
#else
            if (act) *(u32x4*)kp = pack8(a);
#endif
        }
#if FP8_PV
#pragma unroll
        for (int ps = 0; ps < 2; ++ps) { const int c = lane + 64 * ps;
            if (c < 96) { const bf16_t* vp = kv + (c >> 4) * 320 + 192 + (c & 15) * 8; float a[8]; unpack8(*(const u32x4*)vp, a);
                u32x2 w8; w8.x = pack4_fp8(a[0] * rkv, a[1] * rkv, a[2] * rkv, a[3] * rkv); w8.y = pack4_fp8(a[4] * rkv, a[5] * rkv, a[6] * rkv, a[7] * rkv);
                *(LAS u32x2*)(Vs + (r & 63) * 768 + c * 8) = w8; } }
#else
#pragma unroll
        for (int ps = 0; ps < 2; ++ps) { const int c = lane + 64 * ps;
            if (c < 96) { bf16_t* vp = kv + (c >> 4) * 320 + 192 + (c & 15) * 8; float a[8]; unpack8(*(const u32x4*)vp, a);
#pragma unroll
                for (int e = 0; e < 8; ++e) a[e] *= rkv;
                *(u32x4*)vp = pack8(a); } }
#endif
    }
#if FP8_PV
        __syncthreads();
        { const bool latt = tl < TL / 64; const int bb = latt ? (tl >> 5) : ((tl - TL / 64) >> 2), tile = latt ? 4 + (tl & 31) : ((tl - TL / 64) & 3);
#pragma unroll
          for (int it = 0; it < 6; ++it) { const int hh = it, t = F.tid, col = t >> 2, sci = t & 3, ci = sci ^ ((col >> 2) & 3);
              unsigned wq[4];
#pragma unroll
              for (int q = 0; q < 4; ++q) { unsigned wv = 0;
#pragma unroll
                  for (int i2 = 0; i2 < 4; ++i2) { const int kb = ci * 16 + q * 4 + i2, khi = kb >> 5, e = kb & 31, e16 = e & 15, kk = (e16 & 3) + 8 * (e16 >> 2) + 4 * khi + (e >> 4) * 32;
                      wv |= (unsigned)Vs[kk * 768 + hh * 128 + col] << (8 * i2); }
                  wq[q] = wv; }
              *(u32x4*)(F.ws + WS_VT8 + ((size_t)((bb * 6 + hh) * 36 + tile)) * 8192 + col * 64 + sci * 16) = (u32x4){wq[0], wq[1], wq[2], wq[3]}; } }
        __syncthreads();
    }
#endif
}

template <bool OUT8>
__device__ __forceinline__ void phase_ssd_gate(Frame& F, int layer, int nrows) {
    const int gw = F.bid * NWAVES + F.wave, NGW = F.G * NWAVES, lane = F.lane;
    const bf16_t* P = WSP(bf16_t, WS_P); const bf16_t* XA = WSP(bf16_t, WS_XA); const bf16_t* YF = WSP(bf16_t, WS_YF); const bf16_t* YB = WSP(bf16_t, WS_YB); bf16_t* CAT = WSP(bf16_t, WS_CAT);
    const float* dsk = F.in[13] + layer * 12; const float* nw = F.in[14] + layer * 768;
    for (int r = gw; r < nrows; r += NGW) {
        float gl[12]; float ss = 0.f;
#pragma unroll
        for (int j = 0; j < 3; ++j) { const int c = 256 * j + 4 * lane; const float d = dsk[c >> 6];
            const u32x2 yf = *(const u32x2*)(YF + (size_t)r * 768 + c), yb = *(const u32x2*)(YB + (size_t)r * 768 + c), xs = *(const u32x2*)(XA + (size_t)r * XAC + c), z = *(const u32x2*)(P + (size_t)r * PC + PZ + c);
            const float y0 = bf_lo(yf.x) + bf_lo(yb.x) + bf_lo(xs.x) * d, y1 = bf_hi(yf.x) + bf_hi(yb.x) + bf_hi(xs.x) * d, y2 = bf_lo(yf.y) + bf_lo(yb.y) + bf_lo(xs.y) * d, y3 = bf_hi(yf.y) + bf_hi(yb.y) + bf_hi(xs.y) * d;
            gl[j * 4 + 0] = y0 * silu_f(bf_lo(z.x)); gl[j * 4 + 1] = y1 * silu_f(bf_hi(z.x)); gl[j * 4 + 2] = y2 * silu_f(bf_lo(z.y)); gl[j * 4 + 3] = y3 * silu_f(bf_hi(z.y));
            ss += (gl[j * 4] * gl[j * 4] + gl[j * 4 + 1] * gl[j * 4 + 1]) + (gl[j * 4 + 2] * gl[j * 4 + 2] + gl[j * 4 + 3] * gl[j * 4 + 3]); }
        const float rs = rsqrtf(wave_sum(ss) * (1.0f / 768.0f) + EPS);
#pragma unroll
        for (int j = 0; j < 3; ++j) { const int c = 256 * j + 4 * lane; const f32x4 w4 = *(const f32x4*)(nw + c);
            if constexpr (OUT8) *(unsigned*)((unsigned char*)CAT + (size_t)r * DM + c) = pack4_fp8(gl[j * 4] * rs * w4[0], gl[j * 4 + 1] * rs * w4[1], gl[j * 4 + 2] * rs * w4[2], gl[j * 4 + 3] * rs * w4[3]);
            else { u32x2 o; o.x = cvt_pk_bf16(gl[j * 4] * rs * w4[0], gl[j * 4 + 1] * rs * w4[1]); o.y = cvt_pk_bf16(gl[j * 4 + 2] * rs * w4[2], gl[j * 4 + 3] * rs * w4[3]);
                *(u32x2*)(CAT + (size_t)r * DM + c) = o; } }
    }
}

namespace attn {
typedef int i32x4a __attribute__((ext_vector_type(4)));
typedef int i32x8a __attribute__((ext_vector_type(8)));
typedef short s16x4 __attribute__((ext_vector_type(4)));
typedef float f32x16 __attribute__((ext_vector_type(16)));
constexpr int KVBLK = 64;
constexpr float SCALE = 0.07216878364870322f;
#if FP8_PV
constexpr float THR = 3.f, PSHIFT = 4.f;
#else
constexpr float THR = 8.f, PSHIFT = 0.f;
#endif
constexpr int SHM_V = 64 * 128 * 2, SHM_K = 64 * 192 * 2;
constexpr int ATTN_LDS = 2 * SHM_V + 2 * SHM_K + 8 * 64 * 4;
__device__ __forceinline__ void pv8(f32x16 (&o)[4], const LAS unsigned char* Vt, const f32x16& p0, const f32x16& p1, int r32, int hi) {
    i32x8a pa;
#pragma unroll
    for (int g = 0; g < 4; ++g) { int w0 = 0, w1 = 0;
        w0 = __builtin_amdgcn_cvt_pk_fp8_f32(p0[4 * g], p0[4 * g + 1], w0, false); w0 = __builtin_amdgcn_cvt_pk_fp8_f32(p0[4 * g + 2], p0[4 * g + 3], w0, true);
        w1 = __builtin_amdgcn_cvt_pk_fp8_f32(p1[4 * g], p1[4 * g + 1], w1, false); w1 = __builtin_amdgcn_cvt_pk_fp8_f32(p1[4 * g + 2], p1[4 * g + 3], w1, true);
        pa[g] = w0; pa[4 + g] = w1; }
    i32x8a vb[4];
#pragma unroll
    for (int d0 = 0; d0 < 4; ++d0) { const int col = d0 * 32 + r32, f = (col >> 2) & 3; const LAS unsigned char* rowp = Vt + col * 64;
        const i32x4a lo = *(const LAS i32x4a*)(rowp + (((2 * hi) ^ f) << 4)), hi4 = *(const LAS i32x4a*)(rowp + (((2 * hi + 1) ^ f) << 4));
        vb[d0] = __builtin_shufflevector(lo, hi4, 0, 1, 2, 3, 4, 5, 6, 7); }
    asm volatile("s_nop 3" : "+v"(pa));
#pragma unroll
    for (int d0 = 0; d0 < 4; ++d0) asm volatile("v_mfma_f32_32x32x64_f8f6f4 %0, %1, %2, %0" : "+v"(o[d0]) : "v"(pa), "v"(vb[d0]));
}
#define KSWZ8(row, colB) ((row) * 192 + ((colB) ^ ((((row) >> 2) & 3) << 4)))
constexpr int SHM_K8 = 64 * 192;
__device__ __forceinline__ void qkt8(f32x16& p0, f32x16& p1, const LAS unsigned char* Ks, const i32x4a (&q8)[6], int r32, int hi, float bias = 0.f) {
#pragma unroll
    for (int r = 0; r < 16; ++r) { p0[r] = bias; p1[r] = bias; }
    i32x8a ka[3], kb[3];
#pragma unroll
    for (int t = 0; t < 3; ++t) { const int cb = t * 64 + hi * 32;
        const i32x4a a0 = *(const LAS i32x4a*)(Ks + KSWZ8(r32, cb)), a1 = *(const LAS i32x4a*)(Ks + KSWZ8(r32, cb + 16));
        const i32x4a b0 = *(const LAS i32x4a*)(Ks + KSWZ8(32 + r32, cb)), b1 = *(const LAS i32x4a*)(Ks + KSWZ8(32 + r32, cb + 16));
        ka[t] = __builtin_shufflevector(a0, a1, 0, 1, 2, 3, 4, 5, 6, 7); kb[t] = __builtin_shufflevector(b0, b1, 0, 1, 2, 3, 4, 5, 6, 7); }
    asm volatile("s_nop 1" ::: "memory");
#pragma unroll
    for (int t = 0; t < 3; ++t) { const i32x8a qq = __builtin_shufflevector(q8[2 * t], q8[2 * t + 1], 0, 1, 2, 3, 4, 5, 6, 7);
        asm volatile("v_mfma_f32_32x32x64_f8f6f4 %0, %1, %2, %0" : "+v"(p0) : "v"(ka[t]), "v"(qq));
        asm volatile("v_mfma_f32_32x32x64_f8f6f4 %0, %1, %2, %0" : "+v"(p1) : "v"(kb[t]), "v"(qq)); }
    asm volatile("s_nop 15\n\ts_nop 7" : "+v"(p0), "+v"(p1));
}
#define KSWZ(row, colB) ((row) * 384 + ((colB) ^ ((((row) >> 1) & 7) << 4)))
#define SBAR() __builtin_amdgcn_sched_barrier(0)
__device__ __forceinline__ int crow(int r, int hi) { return (r & 3) + 8 * (r >> 2) + 4 * hi; }
__device__ __forceinline__ void partialSM(f32x16& p0, f32x16& p1, float& m_reg, float& mn, float& alpha) {
    constexpr float C = SCALE * 1.4426950408889634f;
    float pmax = p0[0];
#pragma unroll
    for (int r = 1; r < 16; ++r) pmax = fmaxf(pmax, p0[r]);
#pragma unroll
    for (int r = 0; r < 16; ++r) pmax = fmaxf(pmax, p1[r]);
    { auto rr = __builtin_amdgcn_permlane32_swap(__float_as_uint(pmax), __float_as_uint(pmax), false, false); pmax = fmaxf(__uint_as_float(rr[0]), __uint_as_float(rr[1])); }
    if (__builtin_expect(__all(pmax - m_reg <= THR / SCALE), 1)) { mn = m_reg; alpha = 1.f; }
    else { mn = fmaxf(m_reg, pmax); alpha = __builtin_amdgcn_exp2f((m_reg - mn) * C); m_reg = mn; }
    const float mnC = -mn * C + PSHIFT;
#pragma unroll
    for (int r = 0; r < 16; ++r) p0[r] = fmaf(p0[r], C, mnC);
#pragma unroll
    for (int r = 0; r < 16; ++r) p1[r] = fmaf(p1[r], C, mnC);
#pragma unroll
    for (int r = 0; r < 16; ++r) p0[r] = __builtin_amdgcn_exp2f(p0[r]);
}
__device__ __forceinline__ void finishSM(f32x16& p0, f32x16& p1, float alpha, float& l_reg, bf16x8& pa0, bf16x8& pa1, bf16x8& pa2, bf16x8& pa3) {
#pragma unroll
    for (int r = 0; r < 16; ++r) p1[r] = __builtin_amdgcn_exp2f(p1[r]);
    float ps = 0;
#pragma unroll
    for (int r = 0; r < 16; ++r) ps += p0[r];
#pragma unroll
    for (int r = 0; r < 16; ++r) ps += p1[r];
    { auto rr = __builtin_amdgcn_permlane32_swap(__float_as_uint(ps), __float_as_uint(ps), false, false); ps = __uint_as_float(rr[0]) + __uint_as_float(rr[1]); }
    l_reg = l_reg * alpha + ps;
#define PK4(P, BASE, OUT) do { unsigned a0 = cvt_pk_bf16(P[BASE + 0], P[BASE + 1]), a1 = cvt_pk_bf16(P[BASE + 2], P[BASE + 3]);   \
    unsigned b0 = cvt_pk_bf16(P[BASE + 4], P[BASE + 5]), b1 = cvt_pk_bf16(P[BASE + 6], P[BASE + 7]);                              \
    auto r0 = __builtin_amdgcn_permlane32_swap(a0, b0, false, false); auto r1 = __builtin_amdgcn_permlane32_swap(a1, b1, false, false); \
    u32x4 w = {r0[0], r1[0], r0[1], r1[1]}; OUT = __builtin_bit_cast(bf16x8, w); } while (0)
    PK4(p0, 0, pa0); PK4(p0, 8, pa1); PK4(p1, 0, pa2); PK4(p1, 8, pa3);
#undef PK4
}
__device__ __forceinline__ void partialSM8(f32x16& p0, f32x16& p1, float& m_reg, float& alpha, bool first) {
    constexpr float THRL = THR * 1.4426950408889634f;
    float pmax = p0[0];
#pragma unroll
    for (int r = 1; r < 16; ++r) pmax = fmaxf(pmax, p0[r]);
#pragma unroll
    for (int r = 0; r < 16; ++r) pmax = fmaxf(pmax, p1[r]);
    { auto rr = __builtin_amdgcn_permlane32_swap(__float_as_uint(pmax), __float_as_uint(pmax), false, false); pmax = fmaxf(__uint_as_float(rr[0]), __uint_as_float(rr[1])); }
    const float excess = pmax - PSHIFT;
    if (__builtin_expect(!first && __all(excess <= THRL), 1)) alpha = 1.f;
    else { const float delta = first ? excess : fmaxf(excess, 0.f); alpha = first ? 1.f : __builtin_amdgcn_exp2f(-delta); m_reg += delta;
#pragma unroll
        for (int r = 0; r < 16; ++r) { p0[r] -= delta; p1[r] -= delta; } }
#pragma unroll
    for (int r = 0; r < 16; ++r) p0[r] = __builtin_amdgcn_exp2f(p0[r]);
}
__device__ __forceinline__ void finishSM8(f32x16& p0, f32x16& p1, float alpha, float& l_reg) {
#pragma unroll
    for (int r = 0; r < 16; ++r) p1[r] = __builtin_amdgcn_exp2f(p1[r]);
    float ps = 0;
#pragma unroll
    for (int r = 0; r < 16; ++r) ps += p0[r];
#pragma unroll
    for (int r = 0; r < 16; ++r) ps += p1[r];
    { auto rr = __builtin_amdgcn_permlane32_swap(__float_as_uint(ps), __float_as_uint(ps), false, false); ps = __uint_as_float(rr[0]) + __uint_as_float(rr[1]); }
    l_reg = l_reg * alpha + ps;
}
__device__ __forceinline__ void qkt(f32x16& p0, f32x16& p1, const LAS unsigned char* Ks, const bf16x8 (&qr)[12], int r32, int hi) {
#pragma unroll
    for (int r = 0; r < 16; ++r) { p0[r] = 0.f; p1[r] = 0.f; }
#pragma unroll
    for (int d0 = 0; d0 < 12; ++d0) { const int cb = (d0 * 16 + hi * 8) * 2;
        const bf16x8 b0 = *(const LAS bf16x8*)(Ks + KSWZ(r32, cb));
        const bf16x8 b1 = *(const LAS bf16x8*)(Ks + KSWZ(32 + r32, cb));
        p0 = __builtin_amdgcn_mfma_f32_32x32x16_bf16(b0, qr[d0], p0, 0, 0, 0);
        p1 = __builtin_amdgcn_mfma_f32_32x32x16_bf16(b1, qr[d0], p1, 0, 0, 0); }
}
__device__ __forceinline__ int v_st(int k, int c) { const int kk = (k & ~0xC) | ((k & 4) << 1) | ((k & 8) >> 1); return ((kk >> 3) * 4 + (c >> 5)) * 512 + ((kk & 7) * 32 + (c & 31)) * 2; }
__device__ __forceinline__ int v_rd_base(int lane) { return ((lane & 3) << 3) | (((lane >> 2) & 3) << 6) | (((lane >> 4) & 1) << 5) | (((lane >> 5) & 1) << 8); }
constexpr int v_rd_off(int d0, int ks, int half) { return d0 * 512 + ks * 4096 + half * 2048; }
template <int OFF> __device__ __forceinline__ s16x4 tr_read(int vb) { s16x4 r; asm volatile("ds_read_b64_tr_b16 %0, %1 offset:%2" : "=&v"(r) : "v"(vb), "i"(OFF) : "memory"); return r; }
template <int D0> __device__ __forceinline__ void pv_one(f32x16& od, int vb, bf16x8 pa0, bf16x8 pa1, bf16x8 pa2, bf16x8 pa3) {
    const s16x4 l0 = tr_read<v_rd_off(D0, 0, 0)>(vb), h0 = tr_read<v_rd_off(D0, 0, 1)>(vb), l1 = tr_read<v_rd_off(D0, 1, 0)>(vb), h1 = tr_read<v_rd_off(D0, 1, 1)>(vb);
    const s16x4 l2 = tr_read<v_rd_off(D0, 2, 0)>(vb), h2 = tr_read<v_rd_off(D0, 2, 1)>(vb), l3 = tr_read<v_rd_off(D0, 3, 0)>(vb), h3 = tr_read<v_rd_off(D0, 3, 1)>(vb);
    asm volatile("s_waitcnt lgkmcnt(0)" ::: "memory"); SBAR();
#define PKV(L, H) (bf16x8){L[0], L[1], L[2], L[3], H[0], H[1], H[2], H[3]}
    od = __builtin_amdgcn_mfma_f32_32x32x16_bf16(pa0, PKV(l0, h0), od, 0, 0, 0);
    od = __builtin_amdgcn_mfma_f32_32x32x16_bf16(pa1, PKV(l1, h1), od, 0, 0, 0);
    od = __builtin_amdgcn_mfma_f32_32x32x16_bf16(pa2, PKV(l2, h2), od, 0, 0, 0);
    od = __builtin_amdgcn_mfma_f32_32x32x16_bf16(pa3, PKV(l3, h3), od, 0, 0, 0);
#undef PKV
}
template <int D0> __device__ __forceinline__ void pv_rd(int vb, s16x4 (&l)[4], s16x4 (&h)[4]) {
    l[0] = tr_read<v_rd_off(D0, 0, 0)>(vb); h[0] = tr_read<v_rd_off(D0, 0, 1)>(vb); l[1] = tr_read<v_rd_off(D0, 1, 0)>(vb); h[1] = tr_read<v_rd_off(D0, 1, 1)>(vb);
    l[2] = tr_read<v_rd_off(D0, 2, 0)>(vb); h[2] = tr_read<v_rd_off(D0, 2, 1)>(vb); l[3] = tr_read<v_rd_off(D0, 3, 0)>(vb); h[3] = tr_read<v_rd_off(D0, 3, 1)>(vb);
}
__device__ __forceinline__ void pv_mm(f32x16& od, const s16x4 (&l)[4], const s16x4 (&h)[4], bf16x8 pa0, bf16x8 pa1, bf16x8 pa2, bf16x8 pa3) {
#define PKV(L, H) (bf16x8){L[0], L[1], L[2], L[3], H[0], H[1], H[2], H[3]}
    od = __builtin_amdgcn_mfma_f32_32x32x16_bf16(pa0, PKV(l[0], h[0]), od, 0, 0, 0);
    od = __builtin_amdgcn_mfma_f32_32x32x16_bf16(pa1, PKV(l[1], h[1]), od, 0, 0, 0);
    od = __builtin_amdgcn_mfma_f32_32x32x16_bf16(pa2, PKV(l[2], h[2]), od, 0, 0, 0);
    od = __builtin_amdgcn_mfma_f32_32x32x16_bf16(pa3, PKV(l[3], h[3]), od, 0, 0, 0);
#undef PKV
}
__device__ __forceinline__ void pv_d0(f32x16 (&o)[4], int vb, bf16x8 pa0, bf16x8 pa1, bf16x8 pa2, bf16x8 pa3) {
    s16x4 l0[4], h0[4], l1[4], h1[4];
    pv_rd<0>(vb, l0, h0); pv_rd<1>(vb, l1, h1);
    asm volatile("s_waitcnt lgkmcnt(0)" ::: "memory"); SBAR();
    pv_mm(o[0], l0, h0, pa0, pa1, pa2, pa3); pv_mm(o[1], l1, h1, pa0, pa1, pa2, pa3); SBAR();
    pv_rd<2>(vb, l0, h0); pv_rd<3>(vb, l1, h1);
    asm volatile("s_waitcnt lgkmcnt(0)" ::: "memory"); SBAR();
    pv_mm(o[2], l0, h0, pa0, pa1, pa2, pa3); pv_mm(o[3], l1, h1, pa0, pa1, pa2, pa3);
}
template <bool OUT8>
__device__ __forceinline__ void attn_unit(const bf16_t* __restrict__ QR, const bf16_t* __restrict__ KV, const unsigned char* __restrict__ VT, bf16_t* __restrict__ CAT, int qrow0, int b, int h, int NT, LAS unsigned char* lds) {
    const int tid = threadIdx.x, wid = tid >> 6, lane = tid & 63, r32 = lane & 31, hi = lane >> 5;
    LAS unsigned char* V_lds = lds; LAS unsigned char* K_lds = lds + 2 * SHM_V;
    LAS float* ws = (LAS float*)(lds + 2 * SHM_V + 2 * SHM_K) + wid * 64; LAS float* li_l = ws; LAS float* al_l = ws + 32;
    float m_reg = (FP8_QK && FP8_PV) ? 0.f : -1e30f, l_reg = 0; f32x16 o[4];
#if FP8_QK
    i32x4a q8[6];
#else
    bf16x8 qr[12];
#endif
#pragma unroll
    for (int d = 0; d < 4; ++d)
#pragma unroll
        for (int r = 0; r < 16; ++r) o[d][r] = 0.f;
#if FP8_PV
    const unsigned char* Vt8 = VT + (size_t)((b * 6 + h) * 36) * 8192 + tid * 16;
#endif
    const int sr = tid >> 4, sc = (tid & 15) * 8, vst0 = v_st(sr, sc), vst1 = v_st(32 + sr, sc);
    const int vb0 = (int)(unsigned)(size_t)V_lds + v_rd_base(lane);
    const bf16_t* Vh = KV + h * 320 + 192;
#if FP8_QK
    { const unsigned char* Q8 = (const unsigned char*)(QR + (size_t)(qrow0 + wid * 32 + r32) * QC) + h * 192 + hi * 32;
#pragma unroll
      for (int t = 0; t < 3; ++t) { q8[2 * t] = *(const i32x4a*)(Q8 + t * 64); q8[2 * t + 1] = *(const i32x4a*)(Q8 + t * 64 + 16); } }
    const int kc0 = tid, kc1 = tid + 512;
    const int kr0 = kc0 / 12, kq0 = kc0 % 12, kr1 = kc1 / 12, kq1 = kc1 % 12; const bool k1ok = kc1 < 768;
    const int kst0 = KSWZ8(kr0, kq0 * 16), kst1 = KSWZ8(kr1 & 63, kq1 * 16);
    const unsigned char* Kh8 = (const unsigned char*)(KV + h * 320);
    bf16x8 vs0, vs1; i32x4a ks0, ks1, vs8;
#else
    const bf16_t* Qw = QR + (size_t)(qrow0 + wid * 32 + r32) * QC + h * 192 + hi * 8;
#pragma unroll
    for (int d0 = 0; d0 < 12; ++d0) qr[d0] = *(const bf16x8*)(Qw + d0 * 16);
    const int kc0 = tid, kc1 = tid + 512, kc2 = tid + 1024;
    const int kr0 = kc0 / 24, kq0 = kc0 % 24, kr1 = kc1 / 24, kq1 = kc1 % 24, kr2 = kc2 / 24, kq2 = kc2 % 24;
    const int kst0 = KSWZ(kr0, kq0 * 16), kst1 = KSWZ(kr1, kq1 * 16), kst2 = KSWZ(kr2, kq2 * 16);
    const bf16_t* Kh = KV + h * 320;
    bf16x8 vs0, vs1, ks0, ks1, ks2;
#endif
#define TROW(j) ((j) < 4 ? TL + b * CTXL + (j) * 64 : b * SEQ + ((j) - 4) * 64)
#if FP8_QK && FP8_PV
#define SLOAD(j) do { const size_t _r0 = (size_t)TROW(j); vs8 = *(const i32x4a*)(Vt8 + (size_t)(j) * 8192); \
    ks0 = *(const i32x4a*)(Kh8 + (_r0 + kr0) * (KVC * 2) + kq0 * 16); if (k1ok) ks1 = *(const i32x4a*)(Kh8 + (_r0 + kr1) * (KVC * 2) + kq1 * 16); } while (0)
#define SWRITE(bb) do { *(LAS i32x4a*)(V_lds + (bb) * 8192 + tid * 16) = vs8; \
    *(LAS i32x4a*)(K_lds + (bb) * SHM_K8 + kst0) = ks0; if (k1ok) *(LAS i32x4a*)(K_lds + (bb) * SHM_K8 + kst1) = ks1; } while (0)
#define QKT(pp0, pp1, bb) qkt8(pp0, pp1, K_lds + (bb) * SHM_K8, q8, r32, hi)
#elif FP8_QK
#define SLOAD(j) do { const size_t _r0 = (size_t)TROW(j); vs0 = *(const bf16x8*)(Vh + (_r0 + sr) * KVC + sc); vs1 = *(const bf16x8*)(Vh + (_r0 + 32 + sr) * KVC + sc); \
    ks0 = *(const i32x4a*)(Kh8 + (_r0 + kr0) * (KVC * 2) + kq0 * 16); if (k1ok) ks1 = *(const i32x4a*)(Kh8 + (_r0 + kr1) * (KVC * 2) + kq1 * 16); } while (0)
#define SWRITE(bb) do { *(LAS bf16x8*)(V_lds + (bb) * SHM_V + vst0) = vs0; *(LAS bf16x8*)(V_lds + (bb) * SHM_V + vst1) = vs1; \
    *(LAS i32x4a*)(K_lds + (bb) * SHM_K8 + kst0) = ks0; if (k1ok) *(LAS i32x4a*)(K_lds + (bb) * SHM_K8 + kst1) = ks1; } while (0)
#define QKT(pp0, pp1, bb) qkt8(pp0, pp1, K_lds + (bb) * SHM_K8, q8, r32, hi)
#else
#define SLOAD(j) do { const size_t _r0 = (size_t)TROW(j); vs0 = *(const bf16x8*)(Vh + (_r0 + sr) * KVC + sc); vs1 = *(const bf16x8*)(Vh + (_r0 + 32 + sr) * KVC + sc); \
    ks0 = *(const bf16x8*)(Kh + (_r0 + kr0) * KVC + kq0 * 8); ks1 = *(const bf16x8*)(Kh + (_r0 + kr1) * KVC + kq1 * 8); ks2 = *(const bf16x8*)(Kh + (_r0 + kr2) * KVC + kq2 * 8); } while (0)
#define SWRITE(bb) do { *(LAS bf16x8*)(V_lds + (bb) * SHM_V + vst0) = vs0; *(LAS bf16x8*)(V_lds + (bb) * SHM_V + vst1) = vs1; \
    *(LAS bf16x8*)(K_lds + (bb) * SHM_K + kst0) = ks0; *(LAS bf16x8*)(K_lds + (bb) * SHM_K + kst1) = ks1; *(LAS bf16x8*)(K_lds + (bb) * SHM_K + kst2) = ks2; } while (0)
#define QKT(pp0, pp1, bb) qkt(pp0, pp1, K_lds + (bb) * SHM_K, qr, r32, hi)
#endif
    f32x16 p0, p1; float mn, al; bf16x8 pa0, pa1, pa2, pa3;
#if FP8_QK && FP8_PV
    i32x4a vA, kA0, kA1, vB, kB0, kB1;
    const int kr1c = k1ok ? kr1 : kr0, kq1c = k1ok ? kq1 : kq0;
#define SLOADX(V, K0, K1, j) do { const int jj_ = (j) < NT ? (j) : NT - 1; const size_t _r0 = (size_t)TROW(jj_); V = *(const i32x4a*)(Vt8 + (size_t)jj_ * 8192); \
    K0 = *(const i32x4a*)(Kh8 + (_r0 + kr0) * (KVC * 2) + kq0 * 16); K1 = *(const i32x4a*)(Kh8 + (_r0 + kr1c) * (KVC * 2) + kq1c * 16); } while (0)
#define SWRITEX(bb, V, K0, K1) do { *(LAS i32x4a*)(V_lds + (bb) * 8192 + tid * 16) = V; \
    *(LAS i32x4a*)(K_lds + (bb) * SHM_K8 + kst0) = K0; if (k1ok) *(LAS i32x4a*)(K_lds + (bb) * SHM_K8 + kst1) = K1; } while (0)
#define TMATH(j, slot) do { \
        qkt8(p0, p1, K_lds + (slot) * SHM_K8, q8, r32, hi, PSHIFT - m_reg); \
        partialSM8(p0, p1, m_reg, al, (j) == 0); \
        if (__any(al < 1.f)) { if (hi == 0) al_l[r32] = al; asm volatile("s_waitcnt lgkmcnt(0)" ::: "memory"); \
            _Pragma("unroll") for (int d = 0; d < 4; ++d) _Pragma("unroll") for (int r = 0; r < 16; ++r) o[d][r] *= al_l[crow(r, hi)]; } \
        finishSM8(p0, p1, al, l_reg); \
        pv8(o, V_lds + (slot) * 8192, p0, p1, r32, hi); } while (0)
#define APAIR(j, s0, s1, w0, w1) do {     \
        SLOADX(vA, kA0, kA1, (j) + 2); SBAR(); \
        TMATH(j, s0); \
        if ((j) + 2 < NT) SWRITEX(w0, vA, kA0, kA1); \
        SLOADX(vA, kA0, kA1, (j) + 3); SBAR(); \
        TMATH((j) + 1, s1); \
        if ((j) + 2 < NT) SWRITEX(w1, vA, kA0, kA1); \
        __syncthreads(); } while (0)
    SLOADX(vA, kA0, kA1, 0); SLOADX(vB, kB0, kB1, 1);
    SWRITEX(0, vA, kA0, kA1); SWRITEX(1, vB, kB0, kB1); __syncthreads();
    for (int j = 0; j < NT; j += 4) {
        APAIR(j, 0, 1, 2, 3);
        APAIR(j + 2, 2, 3, 0, 1);
    }
#undef TMATH
#undef APAIR
#define ATILE 0
#undef SLOADX
#undef SWRITEX
#undef ATILE
#else
    SLOAD(0); asm volatile("s_waitcnt vmcnt(0)" ::: "memory"); SWRITE(0); __syncthreads();
    for (int j = 0; j < NT; ++j) {
        const int bb = j & 1;
        if (j + 1 < NT) SLOAD(j + 1);
        SBAR();
        QKT(p0, p1, bb);
        partialSM(p0, p1, m_reg, mn, al);
        if (__any(al < 1.f)) { if (hi == 0) al_l[r32] = al; asm volatile("s_waitcnt lgkmcnt(0)" ::: "memory");
#pragma unroll
            for (int d = 0; d < 4; ++d)
#pragma unroll
                for (int r = 0; r < 16; ++r) o[d][r] *= al_l[crow(r, hi)]; }
        finishSM(p0, p1, al, l_reg, pa0, pa1, pa2, pa3); SBAR();
        pv_d0(o, vb0 + bb * SHM_V, pa0, pa1, pa2, pa3);
        if (j + 1 < NT) { asm volatile("s_waitcnt vmcnt(0)" ::: "memory"); SWRITE(bb ^ 1); }
        __syncthreads();
    }
#endif
#if FP8_QK && FP8_PV
    asm volatile("s_nop 15\n\ts_nop 7" : "+v"(o[0]), "+v"(o[1]), "+v"(o[2]), "+v"(o[3]));
#endif
    if (hi == 0) li_l[r32] = l_reg; asm volatile("s_waitcnt lgkmcnt(0)" ::: "memory");
    float rli[16];
#pragma unroll
    for (int r = 0; r < 16; ++r) rli[r] = __builtin_amdgcn_rcpf(li_l[crow(r, hi)]);
    if constexpr (OUT8) { unsigned char* Ow = (unsigned char*)CAT + (size_t)(qrow0 + wid * 32) * DM + 1280 + h * 128;
#pragma unroll
        for (int r = 0; r < 16; ++r) { const int orow = crow(r, hi);
#pragma unroll
            for (int d0 = 0; d0 < 4; ++d0) Ow[(size_t)orow * DM + d0 * 32 + r32] = (unsigned char)(pack4_fp8(o[d0][r] * rli[r], 0.f, 0.f, 0.f) & 0xffu); } }
    else { bf16_t* Ow = CAT + (size_t)(qrow0 + wid * 32) * DM + 1280 + h * 128;
#pragma unroll
        for (int r = 0; r < 16; ++r) { const int orow = crow(r, hi);
#pragma unroll
            for (int d0 = 0; d0 < 4; ++d0) Ow[(size_t)orow * DM + d0 * 32 + r32] = f2bf(o[d0][r] * rli[r]); } }
#undef TROW
#undef SLOAD
#undef SWRITE
#undef QKT
}
#undef KSWZ
#undef KSWZ8
#undef SBAR
}
template <bool OUT8>
__device__ __forceinline__ void phase_attn(Frame& F, int layer) {
    const bf16_t* QR = WSP(bf16_t, WS_QR); const bf16_t* KV = WSP(bf16_t, WS_KVR); bf16_t* CAT = WSP(bf16_t, WS_CAT);
    const int nunits = 768 + (layer == 0 ? 96 : 0);
    for (int uu_ = F.bid; uu_ < nunits * ATT_REP; uu_ += F.G) {
        const int u = uu_ % nunits;
        int b, h, qrow0, NT;
        if (u < 768) { int v = u;
            if (F.G == 256) { const int x = F.bid & 7, jx = F.bid >> 3, r = u >> 8; v = (((r * 8 + x) * 4 + (jx >> 3)) << 3) + (jx & 7); }
            b = v / 48; h = (v % 48) >> 3; qrow0 = b * SEQ + (v & 7) * 256; NT = 36; }
        else { const int uu = u - 768; b = uu / 6; h = uu % 6; qrow0 = TL + b * CTXL; NT = 4; }
        __syncthreads();
        attn::attn_unit<OUT8>(QR, KV, F.ws + WS_VT8, CAT, qrow0, b, h, NT, F.lds);
    }
    __syncthreads();
}

__device__ __forceinline__ void phase_moe_lists(Frame& F) {
    const int NGW = F.G * NWAVES, first = F.bid * NWAVES, tid = F.tid, lane = F.lane, w = F.wave;
    LAS int* red = (LAS int*)F.lds;
    LAS int* tot = red + 128;
    LAS int* wbase = tot + 16;
    const int* cntw = WSP(int, WS_SMALL + SM_CNTW); const int* topi = WSP(int, WS_SMALL + SM_TOPI); const float* topw = WSP(float, WS_SMALL + SM_TOPW);
    int* rowtok = WSP(int, WS_SMALL + SM_ROWTOK); float* roww = WSP(float, WS_SMALL + SM_ROWW); int* tilee = WSP(int, WS_SMALL + SM_TILEE); int* pos = WSP(int, WS_SMALL + SM_POS);
    int tl[8], pl[8];
#pragma unroll
    for (int e = 0; e < 8; ++e) { tl[e] = 0; pl[e] = 0; }
    for (int g = tid; g < NGW; g += NTHR) { const int4 a = *(const int4*)(cntw + (size_t)g * 8), b = *(const int4*)(cntw + (size_t)g * 8 + 4); const int m = g < first ? 1 : 0;
        tl[0] += a.x; tl[1] += a.y; tl[2] += a.z; tl[3] += a.w; tl[4] += b.x; tl[5] += b.y; tl[6] += b.z; tl[7] += b.w;
        pl[0] += m * a.x; pl[1] += m * a.y; pl[2] += m * a.z; pl[3] += m * a.w; pl[4] += m * b.x; pl[5] += m * b.y; pl[6] += m * b.z; pl[7] += m * b.w; }
#pragma unroll
    for (int e = 0; e < 8; ++e) {
#pragma unroll
        for (int o = 1; o < 64; o <<= 1) { tl[e] += __shfl_xor(tl[e], o); pl[e] += __shfl_xor(pl[e], o); }
        if (lane == 0) { red[w * 16 + e] = tl[e]; red[w * 16 + 8 + e] = pl[e]; } }
    __syncthreads();
    if (tid < 16) { int sum = 0;
#pragma unroll
        for (int k = 0; k < 8; ++k) sum += red[k * 16 + tid];
        tot[tid] = sum; }
    __syncthreads();
    if (tid < 64) { const int ww = tid >> 3, e = tid & 7; int sum = tot[8 + e]; for (int k = 0; k < ww; ++k) sum += cntw[(size_t)(first + k) * 8 + e]; wbase[ww * 8 + e] = sum; }
    __syncthreads();
    int off[9]; { int o = 0;
#pragma unroll
        for (int e = 0; e < 8; ++e) { off[e] = o; o += (tot[e] + 255) & ~255; } off[8] = o; }
    { const int gw = first + w, r = gw + NGW * lane; const bool ok = r < TL;
      int e0 = -1, e1 = -1; float w0 = 0.f, w1 = 0.f;
      if (ok) { e0 = topi[2 * r]; e1 = topi[2 * r + 1]; w0 = topw[2 * r]; w1 = topw[2 * r + 1]; }
      const unsigned long long below = (1ull << lane) - 1ull; int p0 = 0, p1 = 0;
#pragma unroll
      for (int e = 0; e < 8; ++e) { const unsigned long long m0 = __ballot(e0 == e), m1 = __ballot(e1 == e);
          const int before = __popcll(m0 & below) + __popcll(m1 & below), base = off[e] + wbase[w * 8 + e];
          if (e0 == e) p0 = base + before; if (e1 == e) p1 = base + before; }
      if (ok) { rowtok[p0] = r; roww[p0] = w0; pos[2 * r] = p0; rowtok[p1] = r; roww[p1] = w1; pos[2 * r + 1] = p1; }
#if FP8_MOE_GU
      { const unsigned char* U8 = F.ws + WS_U; unsigned char* VP = F.ws + WS_VP8;
        for (int k4 = 0; k4 < 64; k4 += 4) { if (gw + NGW * k4 >= TL) break;
            u32x4 a[4], b[4]; float rsv[4] = {0.f, 0.f, 0.f, 0.f};
#pragma unroll
            for (int i = 0; i < 4; ++i) { const int rk = gw + NGW * (k4 + i), rc = rk < TL ? rk : gw;
                a[i] = *(const u32x4*)(U8 + (size_t)rc * DM + lane * 16); b[i] = *(const u32x4*)(U8 + (size_t)rc * DM + 1024 + lane * 16);
                if (I8_MOE_GU != 0) rsv[i] = WSP(float, WS_SMALL + SM_RS)[rc]; }
#pragma unroll
            for (int i = 0; i < 4; ++i) { const int rk = gw + NGW * (k4 + i); const int q0 = __shfl(p0, k4 + i), q1 = __shfl(p1, k4 + i);
                if (rk < TL) {
                    if (I8_MOE_GU != 0 && lane == 0) { WSP(float, WS_SMALL + SM_VPS)[q0] = rsv[i]; WSP(float, WS_SMALL + SM_VPS)[q1] = rsv[i]; }
                    *(u32x4*)(VP + (size_t)q0 * DM + lane * 16) = a[i]; *(u32x4*)(VP + (size_t)q0 * DM + 1024 + lane * 16) = b[i];
                    *(u32x4*)(VP + (size_t)q1 * DM + lane * 16) = a[i]; *(u32x4*)(VP + (size_t)q1 * DM + 1024 + lane * 16) = b[i]; } } } }
#endif
    }
    if (F.bid < 8) { const int e = F.bid; int lo_ = 0, hi_ = 0;
#pragma unroll
        for (int k = 0; k < 8; ++k) if (k == e) { lo_ = off[k] + tot[k]; hi_ = off[k + 1]; }
        for (int p = lo_ + tid; p < hi_; p += NTHR) { rowtok[p] = -1; roww[p] = 0.f; if (I8_MOE_GU != 0) WSP(float, WS_SMALL + SM_VPS)[p] = 0.f; } }
    if (F.bid == (8 % F.G)) { for (int t = tid; t < (off[8] >> 8); t += NTHR) { int e = 0;
#pragma unroll
            for (int k = 1; k < 8; ++k) if (t * 256 >= off[k]) e = k;
            tilee[t] = e; }
        if (tid == 0) tilee[300] = off[8] >> 8; }
    __syncthreads();
}

__device__ __forceinline__ void phase_moe_combine(Frame& F, const float* gateL) {
    const int gw = F.bid * NWAVES + F.wave, NGW = F.G * NWAVES, lane = F.lane;
    const bf16_t* PAIR = WSP(bf16_t, WS_PAIR); const int* pos = WSP(int, WS_SMALL + SM_POS); const float* topw = WSP(float, WS_SMALL + SM_TOPW);
    for (int r = gw; r < TL; r += NGW) {
        const int p0 = pos[2 * r], p1 = pos[2 * r + 1]; const float w0 = topw[2 * r], w1 = topw[2 * r + 1];
        const float* gate = gateL + (size_t)(r >> 11) * 12288;
        float* hrow = F.out + (size_t)r * DM; const bf16_t* h16 = WSP(bf16_t, WS_H16) + (size_t)r * DM;
        const bf16_t* a0 = PAIR + (size_t)p0 * DM; const bf16_t* a1 = PAIR + (size_t)p1 * DM;
#pragma unroll
        for (int j = 0; j < 8; ++j) { const int c = 256 * j + 4 * lane;
            const u32x2 x0 = *(const u32x2*)(a0 + c), x1 = *(const u32x2*)(a1 + c); const f32x4 g4 = *(const f32x4*)(gate + c); const u32x2 hw = *(const u32x2*)(h16 + c); f32x4 hv = (f32x4){bf_lo(hw.x), bf_hi(hw.x), bf_lo(hw.y), bf_hi(hw.y)};
            hv[0] += g4[0] * (w0 * bf_lo(x0.x) + w1 * bf_lo(x1.x)); hv[1] += g4[1] * (w0 * bf_hi(x0.x) + w1 * bf_hi(x1.x));
            hv[2] += g4[2] * (w0 * bf_lo(x0.y) + w1 * bf_lo(x1.y)); hv[3] += g4[3] * (w0 * bf_hi(x0.y) + w1 * bf_hi(x1.y));
            *(f32x4*)(hrow + c) = hv; }
    }
}

#ifdef DBG_ONLY
#define IN(k) ((((k) == 0 ? 0 : (((k) - 1) % 10) + 1) == DBG_ONLY || (DBG_ONLY >= 20 && (k) == DBG_ONLY - 9)) && lo <= (k) && (k) < hi)
#else
#define IN(k) (lo <= (k) && (k) < hi)
#endif
#define SEAM(k) do { if (IN(k) && IN((k) + 1)) xcd_barrier(bar); } while (0)
template <int L>
__device__ __forceinline__ void layer_program(Frame& F, const XcdBarrier& bar, const int lo, const int hi) {
        const int pb = 1 + 10 * L;
        const float* hLin = L == 0 ? F.in[0] : F.out; const float* hCin = L == 0 ? F.in[2] : WSP(float, WS_HC);
        const int nMall = L == 0 ? TT / 256 : TL / 256;
        const float* modL = WSP(float, WS_SMALL + SM_MODL) + (size_t)L * 16 * 12288; const float* modC = WSP(float, WS_SMALL + SM_MODC) + (size_t)L * 12288;
        if (IN(pb + 0)) for (int rep = 0; rep < NREP(pb + 0); ++rep) { phase_norm<false, (((I8_INPROJ >> L) & 1) ? 2 : ((L == 1 && FP8_INPROJ_L1 != 0) ? 1 : 0)), (L == 1)>(F, hLin, hCin, F.in[6] + L * DM, L, 0, TT);
            if constexpr (L == 0 && (I8_INPROJ & 1)) { __syncthreads(); win_i8_items(F, 0, F.bid * NWAVES + F.wave, F.G * NWAVES); } }
        SEAM(pb + 0);
        if (IN(pb + 1)) for (int rep = 0; rep < NREP(pb + 1); ++rep) { constexpr bool Q8 = ((I8_INPROJ >> L) & 1) != 0, F8 = (L == 1 && FP8_INPROJ_L1 != 0); constexpr int KU = (Q8 || F8) ? DM / 2 : DM, MD = Q8 ? 2 : (F8 ? 1 : 0);
            pg8::Gemm g{WSP(bf16_t, WS_U), WSP(bf16_t, WS_WIN) + (size_t)L * PC * DM, KU, KU};
            pg8::EpiBf16 E{WSP(bf16_t, WS_P), PC, F8 ? W8_INV : 1.0f}; pg8::EpiBf16Q EQ{WSP(bf16_t, WS_P), PC, WSP(float, WS_SMALL + SM_RS), WSP(float, WS_SMALL + SM_CS_WIN) + L * PC, FP8_UQKV ? F.ws + WS_C8 : nullptr};
            if constexpr (L == 0) { pg8::StaticOrder S; S.init(TT / 256, PC / 256, F.G, F.bid); S.rep = GREP(pb + 1);
                if constexpr (Q8) pg8::gemm_phase<pg8::EpiBf16Q, pg8::StaticOrder, MD>(F.lds, g, S, EQ); else pg8::gemm_phase<pg8::EpiBf16, pg8::StaticOrder, MD>(F.lds, g, S, E); }
            else { pg8::InProjL1Order S; S.init(F.G, F.bid);
                if constexpr (Q8) pg8::gemm_phase<pg8::EpiBf16Q, pg8::InProjL1Order, MD>(F.lds, g, S, EQ); else pg8::gemm_phase<pg8::EpiBf16, pg8::InProjL1Order, MD>(F.lds, g, S, E); } }
        SEAM(pb + 1);
        if (IN(pb + 2)) for (int rep = 0; rep < NREP(pb + 2); ++rep) {
            phase_conv_pool(F, L);
            __syncthreads();
            { constexpr bool F8 = FP8_UQKV != 0;
              pg8::Gemm g{F8 ? (const bf16_t*)(F.ws + WS_C8) : WSP(bf16_t, WS_P) + PCQ, WSP(bf16_t, WS_WUQ) + (size_t)L * QC * 512, F8 ? 512 : PC, F8 ? 256 : 512}; pg8::StaticOrder S; S.init(nMall, QC / 256, F.G, F.bid); S.rep = GREP(pb + 2);
              pg8::EpiBf16 E{WSP(bf16_t, WS_QR), QC, F8 ? W8_INV : 1.0f}; pg8::gemm_phase<pg8::EpiBf16, pg8::StaticOrder, F8 ? 1 : 0>(F.lds, g, S, E); }
            { constexpr bool F8 = FP8_UQKV != 0;
              pg8::Gemm g{F8 ? (const bf16_t*)(F.ws + WS_C8 + 512) : WSP(bf16_t, WS_P) + PCKV, WSP(bf16_t, WS_WUKV) + (size_t)L * KVC * 512, F8 ? 512 : PC, F8 ? 256 : 512}; pg8::StaticOrder S; S.init(TT / 256, KVC / 256, F.G, F.bid); S.rep = GREP(pb + 2);
              pg8::EpiBf16 E{WSP(bf16_t, WS_KVR), KVC, F8 ? W8_INV : 1.0f}; pg8::gemm_phase<pg8::EpiBf16, pg8::StaticOrder, F8 ? 1 : 0>(F.lds, g, S, E); }
        }
        SEAM(pb + 2);
        if (IN(pb + 3)) for (int rep = 0; rep < NREP(pb + 3); ++rep) {
            phase_ssd(F, L);
            { const int lightbase = F.G < NB * 24 ? NB * 24 - F.G : 0, nlight = F.G - lightbase;
              if (F.bid >= lightbase) { const int lw = (F.bid - lightbase) * NWAVES + F.wave, nlw = nlight * NWAVES;
                  if constexpr (L == 0 && I8_DENSE_GU != 0) { LAS float* scr = (LAS float*)(F.lds + F.wave * 16896);
                      for (int it = lw; it < 2 * 16 * 176; it += nlw) { const int up = it >= 16 * 176; tr_itemq(F.in[24 + up], 2048, FF, F.ws + WS_WGU, 3 + up, WSP(float, WS_SMALL + SM_CS_DGU), scr, it - up * 16 * 176, F.lane); } }
                  if constexpr (L == 0 && (I8_INPROJ & 2)) win_i8_items(F, 1, lw, nlw);
                  moe_weight_items(F, L == 0 ? 0 : MOE_PCT_B, L == 0 ? MOE_PCT_A : 100, lw, nlw); } }
            if (rep == 0) phase_qkv_final(F, L);
            __syncthreads();
            { pg8::Gemm g{WSP(bf16_t, WS_PL), WSP(bf16_t, WS_SMALL + SM_POOLB) + (size_t)L * 512 * 512, 512, 512}; pg8::StaticOrder S; S.init(nMall, 2, F.G, F.G - 1 - F.bid);
              if constexpr ((FP8_WOUT >> L) & 1) { pg8::EpiF8 E{F.ws + WS_CAT + 768, DM, 1.0f}; pg8::gemm_phase<pg8::EpiF8, pg8::StaticOrder>(F.lds, g, S, E); }
              else { pg8::EpiBf16 E{WSP(bf16_t, WS_CAT) + 768, DM}; pg8::gemm_phase<pg8::EpiBf16, pg8::StaticOrder>(F.lds, g, S, E); } }
        }
        SEAM(pb + 3);
        if (IN(pb + 4)) for (int rep = 0; rep < NREP(pb + 4); ++rep) { phase_attn<((FP8_WOUT >> L) & 1) != 0>(F, L); phase_ssd_gate<((FP8_WOUT >> L) & 1) != 0>(F, L, nMall * 256); }
        SEAM(pb + 4);
        if (IN(pb + 5)) for (int rep = 0; rep < NREP(pb + 5); ++rep) { constexpr bool F8 = ((FP8_WOUT >> L) & 1) != 0; constexpr int KU = F8 ? DM / 2 : DM;
            pg8::Gemm g{WSP(bf16_t, WS_CAT), WSP(bf16_t, WS_WOUT) + (size_t)L * DM * DM, KU, KU}; pg8::StaticOrder S; S.init(nMall, DM / 256, F.G, F.bid); S.rep = GREP(pb + 5);
            pg8::EpiResid16<L == 0> E{F.in[0], F.in[2], WSP(bf16_t, WS_H16), modL + 2 * DM, modC + 2 * DM, F8 ? W8_INV : 1.0f}; pg8::gemm_phase<pg8::EpiResid16<L == 0>, pg8::StaticOrder, F8 ? 1 : 0>(F.lds, g, S, E);
            if constexpr (L == 0) { const int full = (nMall * (DM / 256)) % F.G;
                if (rep == 0 && full != 0 && F.bid >= full) moe_weight_items(F, MOE_PCT_A, MOE_PCT_W, (F.bid - full) * NWAVES + F.wave, (F.G - full) * NWAVES); } }
        SEAM(pb + 5);
        if (IN(pb + 6)) for (int rep = 0; rep < NREP(pb + 6); ++rep) { if constexpr (L == 0) phase_norm<false, (I8_DENSE_GU ? 2 : (FP8_DENSE_GU ? 1 : 0)), true>(F, nullptr, nullptr, F.in[7] + L * DM, L, 3, TT); else phase_norm<true, (I8_MOE_GU ? 2 : (FP8_MOE_GU ? 1 : 0)), true>(F, nullptr, nullptr, F.in[7] + L * DM, L, 3, TL); }
        SEAM(pb + 6);
        if constexpr (L == 0) {
            if (IN(pb + 7) && !IN(pb + 6) && IN(pb + 8)) xcd_barrier(bar);
            if (IN(pb + 8)) for (int rep = 0; rep < NREP(pb + 8); ++rep) { constexpr bool Q8 = I8_DENSE_GU != 0, F8 = FP8_DENSE_GU != 0, O8 = FP8_DENSE_DN != 0; constexpr int KU = (Q8 || F8) ? DM / 2 : DM;
                pg8::Gemm g{WSP(bf16_t, WS_U), WSP(bf16_t, WS_WGU), KU, KU}; pg8::StaticOrder S; S.init(TT / 256, 2 * FF / 256, F.G, F.bid); S.rep = GREP(pb + 8);
                if constexpr (Q8) { pg8::EpiGateUpQ<O8> E{F.ws + WS_HID, FF, WSP(float, WS_SMALL + SM_RS), WSP(float, WS_SMALL + SM_CS_DGU)}; E.nkt = (HID_BLOCKED && O8) ? FF / 128 : 0; pg8::gemm_phase<pg8::EpiGateUpQ<O8>, pg8::StaticOrder, 2>(F.lds, g, S, E); }
                else { pg8::EpiGateUp<O8> E{F.ws + WS_HID, FF, F8 ? W8_INV : 1.0f}; E.nkt = (HID_BLOCKED && O8) ? FF / 128 : 0; pg8::gemm_phase<pg8::EpiGateUp<O8>, pg8::StaticOrder, F8 ? 1 : 0>(F.lds, g, S, E); } }
            SEAM(pb + 8);
            if (IN(pb + 9)) for (int rep = 0; rep < NREP(pb + 9); ++rep) { constexpr bool F8 = FP8_DENSE_DN != 0; constexpr int KU = F8 ? FF / 2 : FF;
                pg8::Gemm g{WSP(bf16_t, WS_HID), WSP(bf16_t, WS_WDN), (HID_BLOCKED && F8) ? 64 : KU, KU}; if (HID_BLOCKED && F8) { g.akstep = 256 * 128; g.atile = (size_t)(FF / 128) * 256 * 128; } pg8::StaticOrder S; S.init(TT / 256, DM / 256, F.G, F.bid);
                pg8::EpiResid16<false> E{nullptr, nullptr, WSP(bf16_t, WS_H16), modL + 5 * DM, modC + 5 * DM, F8 ? W8_INV : 1.0f}; pg8::gemm_phase<pg8::EpiResid16<false>, pg8::StaticOrder, F8 ? 1 : 0>(F.lds, g, S, E);
                { const int nu = (TT / 256) * (DM / 256), full = nu % F.G;
                  if (rep == 0 && full != 0 && F.bid >= full) moe_weight_items(F, MOE_PCT_W, MOE_PCT_B, (F.bid - full) * NWAVES + F.wave, (F.G - full) * NWAVES); } }
            SEAM(pb + 9);
        } else {
            if (IN(pb + 7)) for (int rep = 0; rep < NREP(pb + 7); ++rep) phase_moe_lists(F);
            SEAM(pb + 7);
            const int* tilee = WSP(int, WS_SMALL + SM_TILEE);
            if (IN(pb + 8)) for (int rep = 0; rep < NREP(pb + 8); ++rep) { const int ntiles = tilee[300];
                constexpr bool Q8 = I8_MOE_GU != 0, F8 = FP8_MOE_GU != 0; constexpr int KU = (Q8 || F8) ? DM / 2 : DM;
                pg8::Gemm g{(Q8 || F8) ? (const bf16_t*)(F.ws + WS_VP8) : WSP(bf16_t, WS_U), WSP(bf16_t, WS_MWGU), KU, KU}; pg8::MoeOrder S; S.init(ntiles, 2 * FF / 256, F.G, F.bid); S.tile_e = tilee; S.rowtok = WSP(int, WS_SMALL + SM_ROWTOK); S.rows_per_expert = 2 * FF;
                if constexpr (Q8) { pg8::EpiGateUpQ<FP8_MOE_DN != 0> E{F.ws + WS_HID, FF, WSP(float, WS_SMALL + SM_VPS), WSP(float, WS_SMALL + SM_CS_MGU), tilee, 2 * FF}; E.nkt = (HID_BLOCKED && FP8_MOE_DN) ? FF / 128 : 0; pg8::gemm_phase<pg8::EpiGateUpQ<FP8_MOE_DN != 0>, pg8::MoeOrder, 2>(F.lds, g, S, E); }
                else { pg8::EpiGateUp<FP8_MOE_DN != 0> E{F.ws + WS_HID, FF, F8 ? W8_INV : 1.0f}; E.nkt = (HID_BLOCKED && FP8_MOE_DN) ? FF / 128 : 0; pg8::gemm_phase<pg8::EpiGateUp<FP8_MOE_DN != 0>, pg8::MoeOrder, F8 ? 1 : 0>(F.lds, g, S, E); } }
            SEAM(pb + 8);
            if (IN(pb + 9)) for (int rep = 0; rep < NREP(pb + 9); ++rep) { const int ntiles = tilee[300];
                constexpr bool F8 = FP8_MOE_DN != 0; constexpr int KU = F8 ? FF / 2 : FF;
                pg8::Gemm g{WSP(bf16_t, WS_HID), WSP(bf16_t, WS_MWDN), (HID_BLOCKED && F8) ? 64 : KU, KU}; if (HID_BLOCKED && F8) { g.akstep = 256 * 128; g.atile = (size_t)(FF / 128) * 256 * 128; } pg8::MoeOrder S; S.init(ntiles, DM / 256, F.G, F.bid); S.tile_e = tilee; S.rowtok = WSP(int, WS_SMALL + SM_ROWTOK); S.rows_per_expert = DM;
                pg8::EpiBf16 E{WSP(bf16_t, WS_PAIR), DM, F8 ? W8_INV : 1.0f}; pg8::gemm_phase<pg8::EpiBf16, pg8::MoeOrder, F8 ? 1 : 0>(F.lds, g, S, E); }
            SEAM(pb + 9);
            if (IN(pb + 10)) phase_moe_combine(F, modL + 5 * DM);
        }
}
constexpr int NPH = 22;
__global__ void __launch_bounds__(NTHR, 2) mega(Args args) {
    extern __shared__ __attribute__((aligned(16))) unsigned char lds_raw[];
    Frame F;
    F.lds = (LAS unsigned char*)lds_raw; F.tid = threadIdx.x; F.lane = F.tid & 63; F.wave = __builtin_amdgcn_readfirstlane(F.tid >> 6); F.G = gridDim.x; F.bid = blockIdx.x;
    F.in = args.in; F.out = args.out; F.ws = args.ws;
    volatile LAS unsigned* MISC = (volatile LAS unsigned*)(F.lds + LDSCTL_OFF);
    if (F.tid < 64) MISC[F.tid] = 0u;
    __syncthreads();
    const int lo = args.ph_lo, hi = args.ph_hi;
    XcdBarrier bar; bar.bar = (unsigned*)(F.ws + WS_CTL) + CW_BAR; bar.x = 0; bar.st = nullptr;
    if (hi - lo > 1) bar = xcd_barrier_post((unsigned*)(F.ws + WS_CTL) + CW_BAR, MISC + 8);
    if (IN(0)) for (int rep = 0; rep < NREP(0); ++rep) { __syncthreads(); p0_prologue(F); }
    SEAM(0);
    layer_program<0>(F, bar, lo, hi);
    layer_program<1>(F, bar, lo, hi);
#undef IN
#undef SEAM
}

extern "C" void kernel_launch(void* const* d_in, const int* in_sizes, int n_in, void* d_out, int out_size, void* d_ws, size_t ws_size, hipStream_t stream) {
    static int grid = 0;
    if (grid == 0) {
        if (n_in != 31 || out_size != TL * DM || ws_size < WS_END) { fprintf(stderr, "kernel_launch: unexpected shapes (n_in %d, out %d, ws %zu < %zu)\n", n_in, out_size, ws_size, (size_t)WS_END); grid = -1; return; }
        int dev = 0, cus = 0;
        if (hipGetDevice(&dev) != hipSuccess || hipDeviceGetAttribute(&cus, hipDeviceAttributeMultiprocessorCount, dev) != hipSuccess) { grid = -1; return; }
        if (hipFuncSetAttribute((const void*)mega, hipFuncAttributeMaxDynamicSharedMemorySize, LDS_BYTES) != hipSuccess) { fprintf(stderr, "kernel_launch: hipFuncSetAttribute failed\n"); grid = -1; return; }
        grid = cus;
    }
    if (grid < 0) return;
    (void)hipMemsetAsync((char*)d_ws + WS_CTL, 0, CTL_BYTES, stream);
    Args a{};
    for (int i = 0; i < 31; ++i) a.in[i] = (const float*)d_in[i];
    a.out = (float*)d_out; a.ws = (unsigned char*)d_ws;
#if MK_N_LAUNCHES == 1
    a.ph_lo = 0; a.ph_hi = NPH;
    hipLaunchKernelGGL(mega, dim3(grid), dim3(NTHR), LDS_BYTES, stream, a);
#else
    for (int ph = 0; ph < NPH; ++ph) { if (ph == 8) continue; a.ph_lo = ph; a.ph_hi = ph + 1; hipLaunchKernelGGL(mega, dim3(grid), dim3(NTHR), LDS_BYTES, stream, a); }
#endif
}
```
